# Optimizing an MI355X kernel written in HIP

```python
import math
import jax
import jax.numpy as jnp
from jax import lax
import numpy as np

D_MODEL = 1024
BATCH = 4
SEQ = 8192
DEPTH = 2

GRID_W = 64
CTX_LEN = 256

D_MIX = D_MODEL
BRANCH_W = D_MIX // 4

MLA_HEADS = 4
MLA_NOPE = 64
MLA_ROPE = 32
MLA_V = BRANCH_W // MLA_HEADS
Q_LORA = 192
KV_LORA = 128
ROPE_BASE = 10000.0
Q_BLOCK = 128

POOL_WINDOWS = (2, 4, 8, 16)
N_POOL = 4
POOL_GC = BRANCH_W // N_POOL

S5_H = 16
S5_G = BRANCH_W // S5_H
S5_P = 64
DT_MIN = 1e-3
DT_MAX = 1e-1

SGU_HEADS = 4
SGU_HD = BRANCH_W // SGU_HEADS
CHUNK = 128

IN_SPLITS = (KV_LORA,
             KV_LORA + MLA_ROPE,
             KV_LORA + MLA_ROPE + BRANCH_W,
             KV_LORA + MLA_ROPE + BRANCH_W + Q_LORA,
             KV_LORA + MLA_ROPE + 2 * BRANCH_W + Q_LORA,
             KV_LORA + MLA_ROPE + 3 * BRANCH_W + Q_LORA,
             KV_LORA + MLA_ROPE + 4 * BRANCH_W + Q_LORA)
CTX_STATE_COLS = KV_LORA + MLA_ROPE + BRANCH_W
IN_DIM = KV_LORA + MLA_ROPE + 4 * BRANCH_W + Q_LORA + D_MIX

ALPHA = (2 * DEPTH) ** 0.25
BETA = (8 * DEPTH) ** -0.25
LN_EPS = 1e-6

kernel_name = 'hybrid_mla_pool_s5_sgu_flow_block'


def _ln(x):
    xf = x.astype(jnp.float32)
    xc = xf - jnp.mean(xf, -1, keepdims=True)
    return xc * lax.rsqrt(jnp.mean(xc * xc, -1, keepdims=True) + LN_EPS)


def _rms(x, g):
    xf = x.astype(jnp.float32)
    return xf * lax.rsqrt(jnp.mean(xf * xf, -1, keepdims=True) + LN_EPS) * g


def _axial_rope_tables(rows):
    row = jnp.repeat(jnp.arange(rows, dtype=jnp.float32), GRID_W)
    col = jnp.tile(jnp.arange(GRID_W, dtype=jnp.float32), rows)
    nf = MLA_ROPE // 4
    inv = ROPE_BASE ** (-jnp.arange(nf, dtype=jnp.float32) / nf)
    ang = jnp.stack([row[:, None] * inv, col[:, None] * inv], axis=1)
    return jnp.cos(ang), jnp.sin(ang)


def _rope(x, cos, sin):
    shp = x.shape
    xr = x.reshape(shp[:-1] + (2, 2, MLA_ROPE // 4))
    x1, x2 = xr[..., 0, :], xr[..., 1, :]
    cs, sn = cos[:, None], sin[:, None]
    out = jnp.stack([x1 * cs - x2 * sn, x2 * cs + x1 * sn], axis=-2)
    return out.reshape(shp)


def _mla_q(cq, g_q, w_uq):
    b, n = cq.shape[:2]
    q = (_rms(cq, g_q) @ w_uq).reshape(b, n, MLA_HEADS, MLA_NOPE + MLA_ROPE)
    return q[..., :MLA_NOPE], q[..., MLA_NOPE:]


def _mla_kv(ckv, g_kv, w_ukv):
    b, n = ckv.shape[:2]
    kv = (_rms(ckv, g_kv) @ w_ukv).reshape(b, n, MLA_HEADS, MLA_NOPE + MLA_V)
    return kv[..., :MLA_NOPE], kv[..., MLA_NOPE:]


def _mla_attend(q_nope, q_rope, k_nope, k_rope, v):
    b, n = q_nope.shape[:2]
    nb = n // Q_BLOCK
    scale = (MLA_NOPE + MLA_ROPE) ** -0.5
    vf = v.astype(jnp.float32)

    def blocks(t):
        return t.reshape((b, nb, Q_BLOCK) + t.shape[2:]).swapaxes(0, 1)

    def one(qs):
        qn, qr = qs
        s = (jnp.einsum('bqhd,bkhd->bhqk', qn, k_nope)
             + jnp.einsum('bqhr,bkr->bhqk', qr, k_rope))
        p = jax.nn.softmax(s.astype(jnp.float32) * scale, axis=-1)
        return jnp.einsum('bhqk,bkhd->bqhd', p, vf)

    o = lax.map(one, (blocks(q_nope), blocks(q_rope)))
    return o.swapaxes(0, 1).reshape(b, n, MLA_HEADS * MLA_V)


def _pool_mixer(vin, w_pool, scale):
    b, n, _ = vin.shape
    vf = vin.astype(jnp.float32)
    cs = jnp.concatenate([jnp.zeros((b, 1, BRANCH_W), jnp.float32), jnp.cumsum(vf, axis=1)], axis=1)
    t = jnp.arange(n)
    means = []
    for gi, w in enumerate(POOL_WINDOWS):
        lo = jnp.clip(t - w // 2, 0, n)
        hi = jnp.clip(t + (w - w // 2), 0, n)
        csg = cs[..., gi * POOL_GC:(gi + 1) * POOL_GC]
        tot = jnp.take(csg, hi, axis=1) - jnp.take(csg, lo, axis=1)
        means.append(tot / (hi - lo).astype(jnp.float32)[:, None])
    pooled = jnp.concatenate(means, -1) - vf
    y = jnp.einsum('bngc,gcd->bngd', pooled.reshape(b, n, N_POOL, POOL_GC), w_pool)
    return y.reshape(b, n, BRANCH_W) * scale


def _s5_discretise(lam_re, lam_im, log_dt, b_re, b_im):
    lam_re = lam_re.astype(jnp.float32)
    lam_im = lam_im.astype(jnp.float32)
    dt = jnp.exp(log_dt.astype(jnp.float32))[:, None]
    mag = jnp.exp(lam_re * dt)
    lb_re, lb_im = mag * jnp.cos(lam_im * dt), mag * jnp.sin(lam_im * dt)
    nr, ni = lb_re - 1.0, lb_im
    den = lam_re * lam_re + lam_im * lam_im
    k_re = (nr * lam_re + ni * lam_im) / den
    k_im = (ni * lam_re - nr * lam_im) / den
    bb_re = k_re[..., None] * b_re - k_im[..., None] * b_im
    bb_im = k_re[..., None] * b_im + k_im[..., None] * b_re
    return lb_re, lb_im, bb_re, bb_im


def _cscan_combine(e1, e2):
    a1r, a1i, b1r, b1i = e1
    a2r, a2i, b2r, b2i = e2
    return (a2r * a1r - a2i * a1i, a2r * a1i + a2i * a1r,
            a2r * b1r - a2i * b1i + b2r, a2r * b1i + a2i * b1r + b2i)


def _s5_scan(u, disc, reverse, h0):
    lb_re, lb_im, bb_re, bb_im = disc
    n = u.shape[1]
    bu_re = jnp.einsum('bngh,gph->nbgp', u, bb_re)
    bu_im = jnp.einsum('bngh,gph->nbgp', u, bb_im)
    if h0 is not None:
        i0 = n - 1 if reverse else 0
        h0r, h0i = h0
        bu_re = bu_re.at[i0].add(lb_re * h0r - lb_im * h0i)
        bu_im = bu_im.at[i0].add(lb_re * h0i + lb_im * h0r)
    a_re = jnp.broadcast_to(lb_re, (n, 1) + lb_re.shape)
    a_im = jnp.broadcast_to(lb_im, (n, 1) + lb_im.shape)
    _, _, hr, hi = lax.associative_scan(_cscan_combine, (a_re, a_im, bu_re, bu_im),
                                        reverse=reverse, axis=0)
    return hr, hi


def _s5_readout(hr, hi, c_re, c_im):
    return jnp.einsum('nbgp,ghp->bngh', hr, c_re) - jnp.einsum('nbgp,ghp->bngh', hi, c_im)


def _glu(y, w_glu, b_glu):
    g = jax.nn.gelu(y)
    return g * jax.nn.sigmoid(g @ w_glu + b_glu)


def _sgu(u, v, g, bta, w_s, b_s):
    b, n, _ = v.shape
    vn = _ln(v) * g + bta
    vc = vn.reshape(b, n // CHUNK, CHUNK, SGU_HEADS, SGU_HD)
    mixed = jnp.einsum('hts,bcshd->bcthd', w_s, vc) + b_s.T[:, :, None]
    return u * mixed.reshape(b, n, BRANCH_W)


def _layer(x, ctx, c, c_ctx, cos, sin, p, last):
    b, n, _ = x.shape
    nc = ctx.shape[1]
    mod = jax.nn.silu(c.astype(jnp.float32)) @ p['w_mod'] + p['b_mod']
    shift, scale, gate = jnp.split(mod[:, None, :], 3, axis=-1)
    h = _ln(x) * (1.0 + scale) + shift
    ckv, kr, s5_in, cq, pool_in, su, sv, g = jnp.split(h @ p['w_in'], IN_SPLITS, axis=-1)

    sc = jax.nn.silu(c_ctx.astype(jnp.float32))
    if last:
        mod_c = sc @ p['w_mod'][:, :2 * D_MODEL] + p['b_mod'][:2 * D_MODEL]
        shift_c, scale_c = jnp.split(mod_c, 2)
        hc = _ln(ctx) * (1.0 + scale_c) + shift_c
        ckv_c, kr_c, s5_c = jnp.split(hc @ p['w_in'][:, :CTX_STATE_COLS], IN_SPLITS[:2], axis=-1)
    else:
        mod_c = sc @ p['w_mod'] + p['b_mod']
        shift_c, scale_c, gate_c = jnp.split(mod_c, 3)
        hc = _ln(ctx) * (1.0 + scale_c) + shift_c
        ckv_c, kr_c, s5_c, cq_c, pool_c, su_c, sv_c, g_c = jnp.split(hc @ p['w_in'], IN_SPLITS, axis=-1)

    kn_c, v_c = _mla_kv(ckv_c, p['g_kv'], p['w_ukv'])
    kn_l, v_l = _mla_kv(ckv, p['g_kv'], p['w_ukv'])
    qn_l, qr_l = _mla_q(cq, p['g_q'], p['w_uq'])
    qr_l = _rope(qr_l, cos, sin)
    kr_l = _rope(kr[:, :, None, :], cos, sin)[:, :, 0, :]
    att_l = _mla_attend(qn_l, qr_l,
                        jnp.concatenate([kn_c, kn_l], axis=1),
                        jnp.concatenate([kr_c, kr_l], axis=1),
                        jnp.concatenate([v_c, v_l], axis=1))

    pool_l = _pool_mixer(pool_in, p['w_pool'], p['pool_scale'])

    u_l = s5_in.astype(jnp.float32).reshape(b, n, S5_G, S5_H)
    u_c = s5_c.astype(jnp.float32).reshape(b, nc, S5_G, S5_H)
    y_l = s5_in * p['s5_d']
    if not last:
        y_c = s5_c * p['s5_d']
    for d, rev in enumerate((False, True)):
        disc = _s5_discretise(p['lam_re'][d], p['lam_im'][d], p['log_dt'][d],
                              p['s5_b_re'][d], p['s5_b_im'][d])
        hc_r, hc_i = _s5_scan(u_c, disc, rev, None)
        i_end = 0 if rev else nc - 1
        hl_r, hl_i = _s5_scan(u_l, disc, rev, (hc_r[i_end], hc_i[i_end]))
        y_l = y_l + _s5_readout(hl_r, hl_i, p['s5_c_re'][d], p['s5_c_im'][d]).reshape(b, n, BRANCH_W)
        if not last:
            y_c = y_c + _s5_readout(hc_r, hc_i, p['s5_c_re'][d], p['s5_c_im'][d]).reshape(b, nc, BRANCH_W)
    s5_l = _glu(y_l, p['w_glu'], p['b_glu'])

    sgu_l = _sgu(su, sv, p['sgu_g'], p['sgu_b'], p['w_s'], p['b_s'])

    y = (jnp.concatenate([att_l, pool_l, s5_l, sgu_l], axis=-1) * jax.nn.silu(g)) @ p['w_out']
    x_new = (_ln(ALPHA * x + gate * y) * p['ln_g'] + p['ln_b']).astype(x.dtype)
    if last:
        return x_new, None

    qn_c, qr_c = _mla_q(cq_c, p['g_q'], p['w_uq'])
    att_c = _mla_attend(qn_c, qr_c, kn_c, kr_c, v_c)
    pool_cc = _pool_mixer(pool_c, p['w_pool'], p['pool_scale'])
    s5_cc = _glu(y_c, p['w_glu'], p['b_glu'])
    sgu_c = _sgu(su_c, sv_c, p['sgu_g'], p['sgu_b'], p['w_s'], p['b_s'])
    yc = (jnp.concatenate([att_c, pool_cc, s5_cc, sgu_c], axis=-1) * jax.nn.silu(g_c)) @ p['w_out']
    ctx_new = (_ln(ALPHA * ctx + gate_c * yc) * p['ln_g'] + p['ln_b']).astype(ctx.dtype)
    return x_new, ctx_new


def setup_inputs(seed: int = 0) -> dict:
    key = jax.random.key(seed)
    k = jax.random.split(key, 32)
    L = DEPTH
    f32 = jnp.float32

    def nrm(i, shape, s):
        return jax.random.normal(k[i], shape, f32) * s

    n_idx = jnp.arange(S5_P, dtype=f32)
    return {
        'x': nrm(0, (BATCH, SEQ, D_MODEL), 1.0),
        'c': nrm(1, (BATCH, D_MODEL), 1.0),
        'ctx': nrm(2, (BATCH, CTX_LEN, D_MODEL), 1.0),
        'c_ctx': nrm(3, (D_MODEL,), 1.0),
        'w_mod': nrm(4, (L, D_MODEL, 3 * D_MODEL), 0.25 * D_MODEL ** -0.5),
        'b_mod': nrm(5, (L, 3 * D_MODEL), 0.02),
        'w_in': nrm(6, (L, D_MODEL, IN_DIM), D_MODEL ** -0.5),
        'g_q': 1.0 + nrm(7, (L, Q_LORA), 0.02),
        'w_uq': nrm(8, (L, Q_LORA, MLA_HEADS * (MLA_NOPE + MLA_ROPE)), Q_LORA ** -0.5),
        'g_kv': 1.0 + nrm(9, (L, KV_LORA), 0.02),
        'w_ukv': nrm(10, (L, KV_LORA, MLA_HEADS * (MLA_NOPE + MLA_V)), KV_LORA ** -0.5),
        'w_pool': nrm(11, (L, N_POOL, POOL_GC, POOL_GC), POOL_GC ** -0.5),
        'pool_scale': 1.0 + nrm(12, (L, BRANCH_W), 0.02),
        'lam_re': -0.5 + nrm(13, (L, 2, S5_G, S5_P), 0.01),
        'lam_im': math.pi * n_idx + nrm(14, (L, 2, S5_G, S5_P), 0.01),
        'log_dt': jax.random.uniform(k[15], (L, 2, S5_G), dtype=f32,
                                     minval=math.log(DT_MIN), maxval=math.log(DT_MAX)),
        's5_b_re': nrm(16, (L, 2, S5_G, S5_P, S5_H), (2 * S5_H) ** -0.5),
        's5_b_im': nrm(17, (L, 2, S5_G, S5_P, S5_H), (2 * S5_H) ** -0.5),
        's5_c_re': nrm(18, (L, 2, S5_G, S5_H, S5_P), S5_P ** -0.5),
        's5_c_im': nrm(19, (L, 2, S5_G, S5_H, S5_P), S5_P ** -0.5),
        's5_d': nrm(20, (L, BRANCH_W), 1.0),
        'w_glu': nrm(21, (L, BRANCH_W, BRANCH_W), BRANCH_W ** -0.5),
        'b_glu': nrm(22, (L, BRANCH_W), 0.02),
        'sgu_g': 1.0 + nrm(23, (L, BRANCH_W), 0.02),
        'sgu_b': nrm(24, (L, BRANCH_W), 0.02),
        'w_s': nrm(25, (L, SGU_HEADS, CHUNK, CHUNK), CHUNK ** -0.5),
        'b_s': 1.0 + nrm(26, (L, SGU_HEADS, CHUNK), 0.02),
        'w_out': nrm(27, (L, D_MIX, D_MODEL), BETA * D_MIX ** -0.5),
        'ln_g': 1.0 + nrm(28, (L, D_MODEL), 0.02),
        'ln_b': nrm(29, (L, D_MODEL), 0.02),
    }


def reference(x, c, ctx, c_ctx, w_mod, b_mod, w_in, g_q, w_uq, g_kv, w_ukv, w_pool, pool_scale,
              lam_re, lam_im, log_dt, s5_b_re, s5_b_im, s5_c_re, s5_c_im, s5_d, w_glu, b_glu,
              sgu_g, sgu_b, w_s, b_s, w_out, ln_g, ln_b):
    rows = x.shape[1] // GRID_W
    cos, sin = _axial_rope_tables(rows)
    for l in range(DEPTH):
        p = {
            'w_mod': w_mod[l], 'b_mod': b_mod[l], 'w_in': w_in[l],
            'g_q': g_q[l], 'w_uq': w_uq[l], 'g_kv': g_kv[l], 'w_ukv': w_ukv[l],
            'w_pool': w_pool[l], 'pool_scale': pool_scale[l],
            'lam_re': lam_re[l], 'lam_im': lam_im[l], 'log_dt': log_dt[l],
            's5_b_re': s5_b_re[l], 's5_b_im': s5_b_im[l], 's5_c_re': s5_c_re[l], 's5_c_im': s5_c_im[l],
            's5_d': s5_d[l], 'w_glu': w_glu[l], 'b_glu': b_glu[l],
            'sgu_g': sgu_g[l], 'sgu_b': sgu_b[l], 'w_s': w_s[l], 'b_s': b_s[l],
            'w_out': w_out[l], 'ln_g': ln_g[l], 'ln_b': ln_b[l],
        }
        x, ctx = _layer(x, ctx, c, c_ctx, cos, sin, p, l == DEPTH - 1)
    return x
```

```cpp
#include <hip/hip_runtime.h>
#include <hip/hip_cooperative_groups.h>
#include <cstdio>
#include <cstdint>
namespace cg = cooperative_groups;
namespace pg8 {
#define PG8_LAS __attribute__((address_space(3)))
typedef unsigned short bf16_t;
typedef short bf16x8 __attribute__((ext_vector_type(8)));
typedef float f32x4 __attribute__((ext_vector_type(4)));
typedef unsigned u32x4 __attribute__((ext_vector_type(4)));
constexpr int BM = 256, BK = 64, HALF = 128, HTB = HALF * BK * 2  , STAGE_BYTES = 8 * HTB, NXCD = 8, WGM = 8;

__host__ __device__ __forceinline__ int lds_byte(int r, int c) { const int st = (r >> 4) * 2 + (c >> 5), rr = r & 15, cc = c & 31, ob = rr * 64 + cc * 2; return st * 1024 + (ob ^ (((ob >> 9) & 1) << 5)); }
__host__ __device__ __forceinline__ void stage_rc(int b, int& R, int& C) { const int st = b / 1024, sb = b % 1024, swz = sb ^ (((sb >> 9) & 1) << 5); R = (st >> 1) * 16 + swz / 64; C = (st & 1) * 32 + (swz % 64) / 2; }
__host__ __device__ __forceinline__ int perm32(int rho) { const int n = rho >> 4, i = rho & 15; return 8 * (i >> 2) + 4 * n + (i & 3); }

struct Unit { int pm, pn; };
struct Gemm { const bf16_t* A; const bf16_t* Bt; int M, N, K; };

struct StaticOrder {
    int nM, nN, nwg, G, c;
    __host__ __device__ void init(int M, int N, int G_, int c_) { nM = M / BM; nN = N / BM; nwg = nM * nN; G = G_; c = c_; }
    __host__ __device__ bool next(int i, Unit& u) const {
        const long L = (long)i * G + c; if (L >= nwg) return false;
        int wgid = (int)L; { const int q = nwg / NXCD, r = nwg % NXCD, xcd = wgid % NXCD, off = wgid / NXCD; wgid = (xcd < r ? xcd * (q + 1) : r * (q + 1) + (xcd - r) * q) + off; }
        const int nig = WGM * nN, gid = wgid / nig, fm = gid * WGM, gsz = (nM - fm) < WGM ? (nM - fm) : WGM;
        u.pm = fm + ((wgid % nig) % gsz); u.pn = (wgid % nig) / gsz; return true;
    }
    __device__ __forceinline__ void a_ready(const Unit&) const {}
    __device__ __forceinline__ void done(const Unit&) const {}
};
typedef float f32x2v __attribute__((ext_vector_type(2))); typedef __bf16 bf16x2v __attribute__((ext_vector_type(2)));
__device__ __forceinline__ unsigned cvt_pk_bf16(float lo, float hi) { const f32x2v v = {lo, hi}; const bf16x2v b = __builtin_convertvector(v, bf16x2v); return __builtin_bit_cast(unsigned, b); }
template <class Epi, class Sched, bool STAMP = false>
__device__ __forceinline__ void gemm_phase(PG8_LAS unsigned char* lds, const Gemm g, const Sched& S, const Epi& E, unsigned long long* stamps) {
    int tid = threadIdx.x; asm volatile("" : "+v"(tid)); const int wid = __builtin_amdgcn_readfirstlane(tid >> 6), lane = tid & 63, wr = wid >> 2, wc = wid & 3, fr = lane & 15, fq = lane >> 4;
    const int K = g.K, nt = K / BK;
    int ts_lo = 0, ts_hi = 0, nts = 0; const unsigned long long rt_entry = STAMP ? (unsigned long long)wall_clock64() : 0ull;
#define PG8_STAMP() do { if (STAMP && wid == 0 && nts < 64) { const unsigned long long _c = (unsigned long long)clock64(); \
        ts_lo = (lane == nts) ? (int)(unsigned)_c : ts_lo; ts_hi = (lane == nts) ? (int)(unsigned)(_c >> 32) : ts_hi; ++nts; } } while (0)
    PG8_STAMP();
    unsigned voffA[2], voffB[2];
#pragma unroll
    for (int i = 0; i < 2; ++i) { int R, C; stage_rc(tid * 16 + i * 8192, R, C); const int Rb = Epi::PERM ? ((R & ~31) + perm32(R & 31)) : R;
        voffA[i] = (unsigned)(R * K + C) * 2u; voffB[i] = (unsigned)(Rb * K + C) * 2u; }
    const size_t kstep = (size_t)(BK * 2);
    const size_t hstep = (size_t)HALF * K * 2;
    const size_t tstep = 2 * hstep;
    const unsigned ldsw = (unsigned)wid * 1024u;
    const int aoff = lds_byte(wr * 64 + fr, fq * 8), boff = lds_byte(wc * 32 + fr, fq * 8);
#define PG8_SA(b, h) (((b) * 2 + (h)) * HTB)
#define PG8_SB(b, h) ((4 + (b) * 2 + (h)) * HTB)
#define PG8_STAGE(bufoff, gbase, voff) do { _Pragma("unroll") for (int _i = 0; _i < 2; ++_i) \
        __builtin_amdgcn_global_load_lds((const unsigned*)((const char*)(gbase) + (voff)[_i]), (PG8_LAS unsigned*)(lds + (bufoff) + ldsw + _i * 8192), 16, 0, 0); } while (0)
#define PG8_LDA(dst, b, h) do { _Pragma("unroll") for (int m = 0; m < 4; ++m) _Pragma("unroll") for (int k = 0; k < 2; ++k) dst[m][k] = *(const PG8_LAS bf16x8*)(lds + PG8_SA(b, h) + aoff + m * 2048 + k * 1024); } while (0)
#define PG8_LDB(dst, b, h) do { _Pragma("unroll") for (int n = 0; n < 2; ++n) _Pragma("unroll") for (int k = 0; k < 2; ++k) dst[n][k] = *(const PG8_LAS bf16x8*)(lds + PG8_SB(b, h) + boff + n * 2048 + k * 1024); } while (0)
#define PG8_MMA(ai, bj, At, Bt) do { __builtin_amdgcn_s_setprio(1); _Pragma("unroll") for (int m = 0; m < 4; ++m) _Pragma("unroll") for (int n = 0; n < 2; ++n) _Pragma("unroll") for (int k = 0; k < 2; ++k) \
        acc[ai][bj][m][n] = __builtin_amdgcn_mfma_f32_16x16x32_bf16(Bt[n][k], At[m][k], acc[ai][bj][m][n], 0, 0, 0); __builtin_amdgcn_s_setprio(0); } while (0)
#define PG8_WAIT_V(n) asm volatile("s_waitcnt vmcnt(" #n ")" ::: "memory")
#define PG8_WAIT_L(n) asm volatile("s_waitcnt lgkmcnt(" #n ")" ::: "memory")
#define PG8_BAR __builtin_amdgcn_s_barrier()
#define PG8_SCHED __builtin_amdgcn_sched_barrier(0)
    Unit cur, nxt; int ui = 0;
    if (!S.next(0, cur)) return;
    f32x4 acc[2][2][4][2];
#pragma unroll
    for (int a = 0; a < 2; ++a)
#pragma unroll
        for (int b = 0; b < 2; ++b)
#pragma unroll
            for (int m = 0; m < 4; ++m)
#pragma unroll
                for (int n = 0; n < 2; ++n) acc[a][b][m][n] = (f32x4){0.f, 0.f, 0.f, 0.f};
    bf16x8 At[4][2], B0[2][2], B1[2][2];
    const char* cA = (const char*)g.A + (size_t)cur.pm * tstep; const char* cB = (const char*)g.Bt + (size_t)cur.pn * tstep;
    S.a_ready(cur);
    PG8_STAGE(PG8_SB(0, 0), cB, voffB); PG8_STAGE(PG8_SA(0, 0), cA, voffA); PG8_STAGE(PG8_SB(0, 1), cB + hstep, voffB); PG8_STAGE(PG8_SA(0, 1), cA + hstep, voffA);
    if (wr == 1) PG8_BAR;
    PG8_WAIT_V(4); PG8_BAR;
    PG8_STAGE(PG8_SB(1, 0), cB + kstep, voffB); PG8_STAGE(PG8_SA(1, 0), cA + kstep, voffA); PG8_STAGE(PG8_SB(1, 1), cB + hstep + kstep, voffB);
    PG8_WAIT_V(6); PG8_BAR;
    PG8_STAMP();
    for (;;) {
        const bool has_next = S.next(ui + 1, nxt);
        const char* nA = has_next ? (const char*)g.A + (size_t)nxt.pm * tstep : cA; const char* nB = has_next ? (const char*)g.Bt + (size_t)nxt.pn * tstep : cB;
        for (int t = 0; t < nt; t += 2) {
            const bool last = (t == nt - 2);
            const char* a1 = cA + (size_t)(t + 1) * kstep;
            const char* a2 = last ? nA : cA + (size_t)(t + 2) * kstep; const char* b2 = last ? nB : cB + (size_t)(t + 2) * kstep;
            const char* a3 = a2 + kstep; const char* b3 = b2 + kstep;
            if (last && has_next) S.a_ready(nxt);
            PG8_LDB(B0, 0, 0); PG8_SCHED; PG8_LDA(At, 0, 0); PG8_STAGE(PG8_SA(1, 1), a1 + hstep, voffA);
            PG8_WAIT_L(8); PG8_BAR; PG8_WAIT_L(0); PG8_MMA(0, 0, At, B0); PG8_BAR; PG8_SCHED;
            PG8_LDB(B1, 0, 1); PG8_STAGE(PG8_SB(0, 0), b2, voffB);
            PG8_BAR; PG8_WAIT_L(0); PG8_MMA(0, 1, At, B1); PG8_BAR;
            PG8_LDA(At, 0, 1); PG8_STAGE(PG8_SA(0, 0), a2, voffA);
            PG8_BAR; PG8_WAIT_L(0); PG8_MMA(1, 0, At, B0); PG8_BAR; PG8_SCHED;
            PG8_STAGE(PG8_SB(0, 1), b2 + hstep, voffB);
            PG8_WAIT_V(6); PG8_BAR; PG8_MMA(1, 1, At, B1); PG8_BAR;
            PG8_LDB(B0, 1, 0); PG8_SCHED; PG8_LDA(At, 1, 0); PG8_STAGE(PG8_SA(0, 1), a2 + hstep, voffA);
            PG8_WAIT_L(8); PG8_BAR; PG8_WAIT_L(0); PG8_MMA(0, 0, At, B0); PG8_BAR; PG8_SCHED;
            PG8_LDB(B1, 1, 1); PG8_STAGE(PG8_SB(1, 0), b3, voffB);
            PG8_BAR; PG8_WAIT_L(0); PG8_MMA(0, 1, At, B1); PG8_BAR;
            PG8_LDA(At, 1, 1); PG8_STAGE(PG8_SA(1, 0), a3, voffA);
            PG8_BAR; PG8_WAIT_L(0); PG8_MMA(1, 0, At, B0); PG8_BAR; PG8_SCHED;
            PG8_STAGE(PG8_SB(1, 1), b3 + hstep, voffB);
            PG8_WAIT_V(6); PG8_BAR; PG8_MMA(1, 1, At, B1); PG8_BAR;
        }
        PG8_STAMP();
        if constexpr (!Epi::AFTER_DRAIN) { E(acc, cur, wr, wc, fr, fq); S.done(cur); }
        PG8_STAMP();
        if (!has_next) break;
#pragma unroll
        for (int a = 0; a < 2; ++a)
#pragma unroll
            for (int b = 0; b < 2; ++b)
#pragma unroll
                for (int m = 0; m < 4; ++m)
#pragma unroll
                    for (int n = 0; n < 2; ++n) acc[a][b][m][n] = (f32x4){0.f, 0.f, 0.f, 0.f};
        cur = nxt; cA = nA; cB = nB; ++ui;
    }
    PG8_WAIT_V(0);
    if (wr == 0) PG8_BAR;
    PG8_BAR;
    if constexpr (Epi::AFTER_DRAIN) { E.fused(acc, cur, wr, wc, fr, fq, lds, wid, lane); S.done(cur); }
    PG8_STAMP();
    if (STAMP && wid == 0) { stamps[lane] = lane < nts ? (((unsigned long long)(unsigned)ts_hi << 32) | (unsigned)ts_lo) : 0ull;
        if (lane == 62) stamps[62] = rt_entry; if (lane == 63) stamps[63] = (unsigned long long)wall_clock64(); }
#undef PG8_STAMP
#undef PG8_SA
#undef PG8_SB
#undef PG8_STAGE
#undef PG8_LDA
#undef PG8_LDB
#undef PG8_MMA
#undef PG8_WAIT_V
#undef PG8_WAIT_L
#undef PG8_BAR
#undef PG8_SCHED
}
}
namespace pg8 {
struct EpiStoreBf16 {
    static constexpr bool PERM = true, AFTER_DRAIN = false;
    bf16_t* O; int ldc;
    __device__ __forceinline__ void operator()(const f32x4 (&acc)[2][2][4][2], const Unit& u, int wr, int wc, int fr, int fq) const {
        const int row0 = u.pm * BM + wr * 64 + fr; const int col0 = u.pn * BM + wc * 32 + 8 * fq;
#pragma unroll
        for (int ai = 0; ai < 2; ++ai)
#pragma unroll
            for (int m = 0; m < 4; ++m) { bf16_t* rowp = O + (size_t)(row0 + ai * HALF + m * 16) * ldc + col0;
#pragma unroll
                for (int bj = 0; bj < 2; ++bj) { const f32x4 v0 = acc[ai][bj][m][0], v1 = acc[ai][bj][m][1];
                    u32x4 w; w.x = cvt_pk_bf16(v0[0], v0[1]); w.y = cvt_pk_bf16(v0[2], v0[3]); w.z = cvt_pk_bf16(v1[0], v1[1]); w.w = cvt_pk_bf16(v1[2], v1[3]);
                    *(u32x4*)(rowp + bj * HALF) = w; } }
    }
};
}

#define DI __device__ __forceinline__
typedef unsigned short u16;
typedef short bf16x8 __attribute__((ext_vector_type(8)));
typedef short s16x4 __attribute__((ext_vector_type(4)));
typedef float f32x4 __attribute__((ext_vector_type(4)));
typedef float f32x16 __attribute__((ext_vector_type(16)));
typedef unsigned u32x4 __attribute__((ext_vector_type(4)));
typedef unsigned u32x2 __attribute__((ext_vector_type(2)));

constexpr int NLAT = 32768, NCTX = 1024, NTOK = 33792, DM = 1024, NP = 2560, SEQ = 8192, CTXL = 256, SKV = 8448, NIN = 2400;
constexpr int C_CKV = 0, C_KR = 128, C_S5 = 160, C_CQ = 416, C_POOL = 608, C_SU = 864, C_SV = 1120, C_G = 1376;
constexpr float LN_EPS = 1e-6f, ALPHA = 1.4142135623730951f;
constexpr float QSCALE = 0.10206207261596575f * 1.4426950408889634f;
constexpr int KSPLIT = 8;

constexpr size_t OFF_WTIN = 0;
constexpr size_t OFF_WTOUT = OFF_WTIN + (size_t)2 * NP * DM * 2;
constexpr size_t OFF_WTUKV = OFF_WTOUT + (size_t)2 * DM * DM * 2;
constexpr size_t OFF_WTUQ = OFF_WTUKV + (size_t)2 * 512 * 128 * 2;
constexpr size_t OFF_WTGLU = OFF_WTUQ + (size_t)2 * 384 * 192 * 2;
constexpr size_t OFF_WTPOOL = OFF_WTGLU + (size_t)2 * 256 * 256 * 2;
constexpr size_t OFF_WS16 = OFF_WTPOOL + (size_t)2 * 4 * 64 * 64 * 2;
constexpr size_t OFF_MODP = OFF_WS16 + (size_t)2 * 4 * 128 * 128 * 2;
constexpr size_t OFF_LB = OFF_MODP + (size_t)2 * KSPLIT * 5 * 3072 * 4;
constexpr size_t OFF_BBR = OFF_LB + (size_t)4096 * 2 * 4;
constexpr size_t OFF_BBI = OFF_BBR + (size_t)4096 * 16 * 2;
constexpr size_t OFF_CM = OFF_BBI + (size_t)4096 * 16 * 2;
constexpr size_t OFF_ROPE = OFF_CM + (size_t)64 * 16 * 128 * 2;
constexpr size_t OFF_E = OFF_ROPE + (size_t)8192 * 16 * 2 * 4;
constexpr size_t OFF_CTX1 = OFF_E + (size_t)2 * 4 * 66 * 16 * 64 * 2 * 4;
constexpr size_t OFF_H = OFF_CTX1 + (size_t)NCTX * DM * 4;
constexpr size_t OFF_PROJ = OFF_H + (size_t)NTOK * DM * 2;
constexpr size_t OFF_Y = OFF_PROJ + (size_t)NTOK * NP * 2;
constexpr size_t OFF_Q = OFF_Y + (size_t)NTOK * DM * 2;
constexpr size_t OFF_K = OFF_Q + (size_t)16 * SKV * 96 * 2;
constexpr size_t OFF_V = OFF_K + (size_t)16 * SKV * 96 * 2;
constexpr size_t WS_END = OFF_V + (size_t)16 * SKV * 64 * 2;

constexpr int LDS_BYTES = 147456;

struct Params {
    const float *x, *c, *ctx, *c_ctx, *w_mod, *b_mod, *w_in, *g_q, *w_uq, *g_kv, *w_ukv, *w_pool, *pool_scale, *lam_re, *lam_im, *log_dt,
        *b_re, *b_im, *c_re, *c_im, *s5_d, *w_glu, *b_glu, *sgu_g, *sgu_b, *w_s, *b_s, *w_out, *ln_g, *ln_b;
    float* out; unsigned char* ws;
};

DI int otid() { int t = threadIdx.x; asm volatile("" : "+v"(t)); return t; }
typedef float f32x2_ __attribute__((ext_vector_type(2)));
typedef __bf16 bf16x2_ __attribute__((ext_vector_type(2)));
DI unsigned cvtpk(float lo, float hi) { const f32x2_ v = {lo, hi}; const bf16x2_ b = __builtin_convertvector(v, bf16x2_); return __builtin_bit_cast(unsigned, b); }
DI float bflo(unsigned w) { return __uint_as_float(w << 16); }
DI float bfhi(unsigned w) { return __uint_as_float(w & 0xffff0000u); }
DI float bf2f(u16 v) { return __uint_as_float(((unsigned)v) << 16); }
DI u16 f2bf(float x) { return (u16)(cvtpk(x, x) & 0xffffu); }
DI int crow(int r, int hi) { return (r & 3) + 8 * (r >> 2) + 4 * hi; }
DI float wave_sum(float v) {
#pragma unroll
    for (int o = 32; o >= 1; o >>= 1) v += __shfl_xor(v, o);
    return v;
}
DI float fexp2(float x) { return __builtin_amdgcn_exp2f(x); }
DI float sigmoidf_(float x) { return __builtin_amdgcn_rcpf(1.f + fexp2(-1.4426950408889634f * x)); }
DI float siluf_(float x) { return x * sigmoidf_(x); }
DI float gelu_tanh(float y) { const float u = 0.7978845608028654f * (y + 0.044715f * y * y * y); return y * sigmoidf_(2.f * u); }
#define MFMA32(a, b, c) __builtin_amdgcn_mfma_f32_32x32x16_bf16((a), (b), (c), 0, 0, 0)
#define MFMA16(a, b, c) __builtin_amdgcn_mfma_f32_16x16x32_bf16((a), (b), (c), 0, 0, 0)

DI void sincos_acc(float x, float& s, float& c) {
    const float k = rintf(x * 0.6366197723675814f);
    float r = fmaf(k, -1.5707963705062866f, x);
    r = fmaf(k, 4.371138828673793e-8f, r);
    const int q = ((int)k) & 3;
    const float r2 = r * r;
    const float sp = fmaf(r * r2, fmaf(r2, fmaf(r2, -1.9515295891e-4f, 8.3321608736e-3f), -1.6666654611e-1f), r);
    const float cp = fmaf(r2 * r2, fmaf(r2, fmaf(r2, 2.443315711809948e-5f, -1.388731625493765e-3f), 4.166664568298827e-2f), fmaf(r2, -0.5f, 1.f));
    const float s0 = (q & 1) ? cp : sp, c0 = (q & 1) ? sp : cp;
    s = (q & 2) ? -s0 : s0;
    c = ((q == 1) || (q == 2)) ? -c0 : c0;
}

DI void transpose_tile(const float* __restrict__ src, int C, int r0, int c0, u16* __restrict__ dst, int ldd, float* tile) {
    const int tid = otid();
#pragma unroll
    for (int i = 0; i < 2; ++i) {
        const int r = (tid >> 4) + 32 * i, c = (tid & 15) * 4;
        f32x4 v = {0.f, 0.f, 0.f, 0.f};
        if (c0 + c < C) v = *(const f32x4*)(src + (size_t)(r0 + r) * C + c0 + c);
        tile[r * 65 + c] = v[0]; tile[r * 65 + c + 1] = v[1]; tile[r * 65 + c + 2] = v[2]; tile[r * 65 + c + 3] = v[3];
    }
    __syncthreads();
    const int c = tid >> 3, r8 = (tid & 7) * 8;
    if (c0 + c < C) {
        u32x4 w;
        w.x = cvtpk(tile[(r8 + 0) * 65 + c], tile[(r8 + 1) * 65 + c]); w.y = cvtpk(tile[(r8 + 2) * 65 + c], tile[(r8 + 3) * 65 + c]);
        w.z = cvtpk(tile[(r8 + 4) * 65 + c], tile[(r8 + 5) * 65 + c]); w.w = cvtpk(tile[(r8 + 6) * 65 + c], tile[(r8 + 7) * 65 + c]);
        *(u32x4*)(dst + (size_t)(c0 + c) * ldd + r0 + r8) = w;
    }
    __syncthreads();
}

DI void phase_w(const Params& p, unsigned char* smem) {
    float* tile = (float*)smem;
    const int tid = otid();
    u16* wtin = (u16*)(p.ws + OFF_WTIN); u16* wtout = (u16*)(p.ws + OFF_WTOUT); u16* wtukv = (u16*)(p.ws + OFF_WTUKV); u16* wtuq = (u16*)(p.ws + OFF_WTUQ);
    u16* wtglu = (u16*)(p.ws + OFF_WTGLU); u16* wtpool = (u16*)(p.ws + OFF_WTPOOL); u16* ws16 = (u16*)(p.ws + OFF_WS16);
    constexpr int T_IN = 16 * 38, T_OUT = 256, T_UKV = 16, T_UQ = 18, T_GLU = 16, T_POOL = 4, T_L = T_IN + T_OUT + T_UKV + T_UQ + T_GLU + T_POOL;
    constexpr int U_TR = 2 * T_L, U_PAD = 80, U_WS = 32, U_MOD = 2 * 6 * KSPLIT, U_S5 = 8, U_ROPE = 256;
    constexpr int U_TOT = U_TR + U_PAD + U_WS + U_MOD + U_S5 + U_ROPE;
    for (int u = blockIdx.x; u < U_TOT; u += gridDim.x) {
        int v = u;
        if (v < U_TR) {
            const int l = v / T_L; int t = v % T_L;
            if (t < T_IN) { transpose_tile(p.w_in + (size_t)l * DM * NIN, NIN, (t / 38) * 64, (t % 38) * 64, wtin + (size_t)l * NP * DM, DM, tile); continue; }
            t -= T_IN;
            if (t < T_OUT) { transpose_tile(p.w_out + (size_t)l * DM * DM, DM, (t / 16) * 64, (t % 16) * 64, wtout + (size_t)l * DM * DM, DM, tile); continue; }
            t -= T_OUT;
            if (t < T_UKV) { transpose_tile(p.w_ukv + (size_t)l * 128 * 512, 512, (t / 8) * 64, (t % 8) * 64, wtukv + (size_t)l * 512 * 128, 128, tile); continue; }
            t -= T_UKV;
            if (t < T_UQ) { transpose_tile(p.w_uq + (size_t)l * 192 * 384, 384, (t / 6) * 64, (t % 6) * 64, wtuq + (size_t)l * 384 * 192, 192, tile); continue; }
            t -= T_UQ;
            if (t < T_GLU) { transpose_tile(p.w_glu + (size_t)l * 256 * 256, 256, (t / 4) * 64, (t % 4) * 64, wtglu + (size_t)l * 256 * 256, 256, tile); continue; }
            t -= T_GLU;
            transpose_tile(p.w_pool + (size_t)(l * 4 + t) * 64 * 64, 64, 0, 0, wtpool + (size_t)(l * 4 + t) * 64 * 64, 64, tile);
            continue;
        }
        v -= U_TR;
        if (v < U_PAD) {
            const int e = (v * 512 + tid) * 8; const int l = e / (160 * 1024), o = e % (160 * 1024);
            *(u32x4*)(wtin + (size_t)l * NP * DM + (size_t)NIN * DM + o) = (u32x4){0u, 0u, 0u, 0u};
            continue;
        }
        v -= U_PAD;
        if (v < U_WS) {
            const int e = (v * 512 + tid) * 8;
            const f32x4 a = *(const f32x4*)(p.w_s + e), b = *(const f32x4*)(p.w_s + e + 4);
            u32x4 w; w.x = cvtpk(a[0], a[1]); w.y = cvtpk(a[2], a[3]); w.z = cvtpk(b[0], b[1]); w.w = cvtpk(b[2], b[3]);
            *(u32x4*)(ws16 + e) = w;
            continue;
        }
        v -= U_WS;
        if (v < U_MOD) {
            const int l = v / (6 * KSPLIT), chunk = (v / KSPLIT) % 6, ks = v % KSPLIT;
            constexpr int KL = DM / KSPLIT;
            float* sv = (float*)smem;
            for (int i = tid; i < 5 * KL; i += 512) { const int j = i / KL, kk = i % KL; const float a = (j < 4) ? p.c[j * DM + ks * KL + kk] : p.c_ctx[ks * KL + kk]; sv[i] = siluf_(a); }
            __syncthreads();
            const int n = chunk * 512 + tid;
            const float* wp = p.w_mod + (size_t)l * DM * 3072 + (size_t)(ks * KL) * 3072 + n;
            float a0 = 0.f, a1 = 0.f, a2 = 0.f, a3 = 0.f, a4 = 0.f;
#pragma unroll 8
            for (int kk = 0; kk < KL; ++kk) { const float w = wp[(size_t)kk * 3072]; a0 = fmaf(sv[kk], w, a0); a1 = fmaf(sv[KL + kk], w, a1); a2 = fmaf(sv[2 * KL + kk], w, a2); a3 = fmaf(sv[3 * KL + kk], w, a3); a4 = fmaf(sv[4 * KL + kk], w, a4); }
            float* mp = (float*)(p.ws + OFF_MODP) + (size_t)((l * KSPLIT + ks) * 5) * 3072 + n;
            mp[0] = a0; mp[3072] = a1; mp[2 * 3072] = a2; mp[3 * 3072] = a3; mp[4 * 3072] = a4;
            __syncthreads();
            continue;
        }
        v -= U_MOD;
        if (v < U_S5) {
            const int idx = v * 512 + tid;
            const float lr = p.lam_re[idx], li = p.lam_im[idx], dt = expf(p.log_dt[idx >> 6]);
            const float mag = expf(lr * dt); float sn, cs; sincos_acc(li * dt, sn, cs);
            const float lbr = mag * cs, lbi = mag * sn, nr = lbr - 1.f, ni = lbi, den = lr * lr + li * li;
            const float kr = (nr * lr + ni * li) / den, ki = (ni * lr - nr * li) / den;
            float* lb = (float*)(p.ws + OFF_LB); lb[idx * 2] = lbr; lb[idx * 2 + 1] = lbi;
            u16* bbr = (u16*)(p.ws + OFF_BBR) + (size_t)idx * 16; u16* bbi = (u16*)(p.ws + OFF_BBI) + (size_t)idx * 16;
            u16* cm = (u16*)(p.ws + OFF_CM);
            const int pp = idx & 63;
            for (int h = 0; h < 16; ++h) {
                const float br = p.b_re[(size_t)idx * 16 + h], bi = p.b_im[(size_t)idx * 16 + h];
                bbr[h] = f2bf(kr * br - ki * bi); bbi[h] = f2bf(kr * bi + ki * br);
                const size_t ci = ((size_t)(idx >> 6) * 16 + h) * 64 + pp;
                *(unsigned*)(cm + ((size_t)(idx >> 6) * 16 + h) * 128 + 2 * pp) = cvtpk(p.c_re[ci], -p.c_im[ci]);
            }
            continue;
        }
        v -= U_S5;
        {
            const int it = v * 512 + tid; const int t = it >> 4, a = (it >> 3) & 1, f = it & 7;
            const float pos = (float)(a ? (t & 63) : (t >> 6));
            const float inv = exp2f(-(float)f * 0.125f * 13.287712379549449f);
            float sn, cs; sincos_acc(pos * inv, sn, cs);
            float* rp = (float*)(p.ws + OFF_ROPE) + (size_t)it * 2; rp[0] = cs; rp[1] = sn;
        }
    }
}

DI void load_mod(const Params& p, int l, int j, int which, float* dst) {
    const float* mp = (const float*)(p.ws + OFF_MODP);
    for (int c = otid(); c < DM; c += 512) {
        float v = p.b_mod[l * 3072 + which * DM + c];
#pragma unroll
        for (int ks = 0; ks < KSPLIT; ++ks) v += mp[(size_t)((l * KSPLIT + ks) * 5 + j) * 3072 + which * DM + c];
        dst[c] = v;
    }
}

DI void phase_a(const Params& p, unsigned char* smem) {
    float* shift = (float*)smem; float* scale = shift + DM;
    u16* hb = (u16*)(p.ws + OFF_H);
    const int tid = otid(), wid = __builtin_amdgcn_readfirstlane(tid >> 6), lane = tid & 63;
    for (int u = blockIdx.x; u < NTOK / 128; u += gridDim.x) {
        const int r0 = u * 128; const int j = (r0 < NLAT) ? (r0 >> 13) : 4;
        __syncthreads();
        load_mod(p, 0, j, 0, shift); load_mod(p, 0, j, 1, scale);
        __syncthreads();
        for (int rr = 0; rr < 16; ++rr) {
            const int row = r0 + wid * 16 + rr;
            const float* xp = (row < NLAT) ? p.x + (size_t)row * DM : p.ctx + (size_t)(row - NLAT) * DM;
            f32x4 v[4]; float s = 0.f;
#pragma unroll
            for (int i = 0; i < 4; ++i) { v[i] = *(const f32x4*)(xp + i * 256 + lane * 4); s += v[i][0] + v[i][1] + v[i][2] + v[i][3]; }
            const float mean = wave_sum(s) * (1.f / DM);
            float q = 0.f;
#pragma unroll
            for (int i = 0; i < 4; ++i)
#pragma unroll
                for (int k = 0; k < 4; ++k) { const float d = v[i][k] - mean; q += d * d; }
            const float rstd = rsqrtf(wave_sum(q) * (1.f / DM) + LN_EPS);
#pragma unroll
            for (int i = 0; i < 4; ++i) {
                const int c = i * 256 + lane * 4; float o[4];
#pragma unroll
                for (int k = 0; k < 4; ++k) o[k] = (v[i][k] - mean) * rstd * (1.f + scale[c + k]) + shift[c + k];
                u32x2 w; w.x = cvtpk(o[0], o[1]); w.y = cvtpk(o[2], o[3]);
                *(u32x2*)(hb + (size_t)row * DM + c) = w;
            }
        }
    }
}

DI void phase_f(const Params& p, int l, unsigned char* smem) {
    float* gate = (float*)smem; float* shift = gate + DM; float* scale = shift + DM;
    const u16* yb = (const u16*)(p.ws + OFF_Y);
    u16* hb = (u16*)(p.ws + OFF_H);
    float* ctx1 = (float*)(p.ws + OFF_CTX1);
    const int tid = otid(), wid = __builtin_amdgcn_readfirstlane(tid >> 6), lane = tid & 63;
    const int nrows = l ? NLAT : NTOK;
    const float* lg = p.ln_g + l * DM; const float* lbv = p.ln_b + l * DM;
    for (int u = blockIdx.x; u < nrows / 128; u += gridDim.x) {
        const int r0 = u * 128; const int j = (r0 < NLAT) ? (r0 >> 13) : 4;
        __syncthreads();
        load_mod(p, l, j, 2, gate);
        if (l == 0) { load_mod(p, 1, j, 0, shift); load_mod(p, 1, j, 1, scale); }
        __syncthreads();
        for (int rr = 0; rr < 16; ++rr) {
            const int row = r0 + wid * 16 + rr;
            const float* xp; float* op;
            if (l == 0) { xp = (row < NLAT) ? p.x + (size_t)row * DM : p.ctx + (size_t)(row - NLAT) * DM; op = (row < NLAT) ? p.out + (size_t)row * DM : ctx1 + (size_t)(row - NLAT) * DM; }
            else { xp = p.out + (size_t)row * DM; op = p.out + (size_t)row * DM; }
            f32x4 v[4]; float s = 0.f;
#pragma unroll
            for (int i = 0; i < 4; ++i) {
                const int c = i * 256 + lane * 4;
                const f32x4 xv = *(const f32x4*)(xp + c); const u32x2 yw = *(const u32x2*)(yb + (size_t)row * DM + c);
                v[i][0] = ALPHA * xv[0] + gate[c] * bflo(yw.x); v[i][1] = ALPHA * xv[1] + gate[c + 1] * bfhi(yw.x);
                v[i][2] = ALPHA * xv[2] + gate[c + 2] * bflo(yw.y); v[i][3] = ALPHA * xv[3] + gate[c + 3] * bfhi(yw.y);
                s += v[i][0] + v[i][1] + v[i][2] + v[i][3];
            }
            const float mean = wave_sum(s) * (1.f / DM);
            float q = 0.f;
#pragma unroll
            for (int i = 0; i < 4; ++i)
#pragma unroll
                for (int k = 0; k < 4; ++k) { const float d = v[i][k] - mean; q += d * d; }
            const float rstd = rsqrtf(wave_sum(q) * (1.f / DM) + LN_EPS);
            float s2 = 0.f;
#pragma unroll
            for (int i = 0; i < 4; ++i) {
                const int c = i * 256 + lane * 4;
                const f32x4 g4 = *(const f32x4*)(lg + c), b4 = *(const f32x4*)(lbv + c);
#pragma unroll
                for (int k = 0; k < 4; ++k) { v[i][k] = (v[i][k] - mean) * rstd * g4[k] + b4[k]; s2 += v[i][k]; }
                *(f32x4*)(op + c) = v[i];
            }
            if (l == 0) {
                const float m2 = wave_sum(s2) * (1.f / DM);
                float q2 = 0.f;
#pragma unroll
                for (int i = 0; i < 4; ++i)
#pragma unroll
                    for (int k = 0; k < 4; ++k) { const float d = v[i][k] - m2; q2 += d * d; }
                const float rs2 = rsqrtf(wave_sum(q2) * (1.f / DM) + LN_EPS);
#pragma unroll
                for (int i = 0; i < 4; ++i) {
                    const int c = i * 256 + lane * 4; float o[4];
#pragma unroll
                    for (int k = 0; k < 4; ++k) o[k] = (v[i][k] - m2) * rs2 * (1.f + scale[c + k]) + shift[c + k];
                    u32x2 w; w.x = cvtpk(o[0], o[1]); w.y = cvtpk(o[2], o[3]);
                    *(u32x2*)(hb + (size_t)row * DM + c) = w;
                }
            }
        }
    }
}

DI void phase_gemm(const u16* A, const u16* Bt, u16* O, int M, int N, int ldc, unsigned char* smem) {
    pg8::Gemm g; g.A = A; g.Bt = Bt; g.M = M; g.N = N; g.K = DM;
    pg8::StaticOrder S; S.init(M, N, (int)gridDim.x, (int)blockIdx.x);
    pg8::EpiStoreBf16 E; E.O = O; E.ldc = ldc;
    pg8::gemm_phase<pg8::EpiStoreBf16, pg8::StaticOrder, false>((PG8_LAS unsigned char*)smem, g, S, E, nullptr);
}

DI void row_info(int r, int& b, int& t, int& isctx) { if (r < NLAT) { b = r >> 13; t = r & 8191; isctx = 0; } else { const int rc = r - NLAT; b = rc >> 8; t = rc & 255; isctx = 1; } }

DI void unit_mla(const Params& p, int l, int u, unsigned char* smem) {
    const int tid = otid(), wid = __builtin_amdgcn_readfirstlane(tid >> 6), lane = tid & 63, r32 = lane & 31, hi = lane >> 5;
    const u16* proj = (const u16*)(p.ws + OFF_PROJ);
    u16* Qg = (u16*)(p.ws + OFF_Q); u16* Kg = (u16*)(p.ws + OFF_K); u16* Vg = (u16*)(p.ws + OFF_V);
    const float* rope = (const float*)(p.ws + OFF_ROPE);
    u16* Akv = (u16*)smem;
    u16* Aq = (u16*)(smem + 64 * 272);
    const int r0 = u * 64; int b, t0, isctx; row_info(r0, b, t0, isctx);
    const int s0 = isctx ? t0 : 256 + t0;
    __syncthreads();
    for (int i = 0; i < 8; ++i) {
        const int m = wid * 8 + i; const u16* pr = proj + (size_t)(r0 + m) * NP;
        { const unsigned w = *(const unsigned*)(pr + C_CKV + 2 * lane); const float a = bflo(w), c = bfhi(w);
          const float rs = rsqrtf(wave_sum(a * a + c * c) * (1.f / 128.f) + LN_EPS);
          const float g0 = p.g_kv[l * 128 + 2 * lane], g1 = p.g_kv[l * 128 + 2 * lane + 1];
          *(unsigned*)(Akv + m * 136 + 2 * lane) = cvtpk(a * rs * g0, c * rs * g1); }
        { const unsigned w0 = *(const unsigned*)(pr + C_CQ + 2 * lane); const float a = bflo(w0), c = bfhi(w0);
          float a2 = 0.f, c2 = 0.f; if (lane < 32) { const unsigned w1 = *(const unsigned*)(pr + C_CQ + 128 + 2 * lane); a2 = bflo(w1); c2 = bfhi(w1); }
          const float rs = rsqrtf(wave_sum(a * a + c * c + a2 * a2 + c2 * c2) * (1.f / 192.f) + LN_EPS);
          *(unsigned*)(Aq + m * 200 + 2 * lane) = cvtpk(a * rs * p.g_q[l * 192 + 2 * lane], c * rs * p.g_q[l * 192 + 2 * lane + 1]);
          if (lane < 32) *(unsigned*)(Aq + m * 200 + 128 + 2 * lane) = cvtpk(a2 * rs * p.g_q[l * 192 + 128 + 2 * lane], c2 * rs * p.g_q[l * 192 + 128 + 2 * lane + 1]); }
        if (lane < 16) {
            const int a = lane >> 3, f = lane & 7;
            float x1 = bf2f(pr[C_KR + a * 16 + f]), x2 = bf2f(pr[C_KR + a * 16 + 8 + f]);
            if (!isctx) { const float cs = rope[((size_t)(t0 + m) * 16 + lane) * 2], sn = rope[((size_t)(t0 + m) * 16 + lane) * 2 + 1];
                const float y1 = x1 * cs - x2 * sn, y2 = x2 * cs + x1 * sn; x1 = y1; x2 = y2; }
            const u16 o1 = f2bf(x1), o2 = f2bf(x2);
#pragma unroll
            for (int h = 0; h < 4; ++h) { u16* kp = Kg + ((size_t)(b * 4 + h) * SKV + s0 + m) * 96 + 64 + a * 16 + f; kp[0] = o1; kp[8] = o2; }
        }
    }
    __syncthreads();
    {
        const int h = wid >> 1, part = wid & 1, n0 = h * 128 + part * 64;
        const u16* W = (const u16*)(p.ws + OFF_WTUKV) + (size_t)l * 512 * 128;
        f32x16 acc[2][2];
#pragma unroll
        for (int i = 0; i < 2; ++i)
#pragma unroll
            for (int j = 0; j < 2; ++j)
#pragma unroll
                for (int r = 0; r < 16; ++r) acc[i][j][r] = 0.f;
#pragma unroll
        for (int ks = 0; ks < 8; ++ks) {
            bf16x8 af[2], bf[2];
#pragma unroll
            for (int i = 0; i < 2; ++i) af[i] = *(const bf16x8*)(Akv + (i * 32 + r32) * 136 + ks * 16 + hi * 8);
#pragma unroll
            for (int j = 0; j < 2; ++j) bf[j] = *(const bf16x8*)(W + (size_t)(n0 + j * 32 + r32) * 128 + ks * 16 + hi * 8);
#pragma unroll
            for (int i = 0; i < 2; ++i)
#pragma unroll
                for (int j = 0; j < 2; ++j) acc[i][j] = MFMA32(bf[j], af[i], acc[i][j]);
        }
        u16* dst = part ? Vg : Kg; const int ld = part ? 64 : 96;
#pragma unroll
        for (int i = 0; i < 2; ++i)
#pragma unroll
            for (int j = 0; j < 2; ++j)
#pragma unroll
                for (int r4 = 0; r4 < 4; ++r4) {
                    u32x2 w; w.x = cvtpk(acc[i][j][4 * r4], acc[i][j][4 * r4 + 1]); w.y = cvtpk(acc[i][j][4 * r4 + 2], acc[i][j][4 * r4 + 3]);
                    *(u32x2*)(dst + ((size_t)(b * 4 + h) * SKV + s0 + i * 32 + r32) * ld + j * 32 + 8 * r4 + 4 * hi) = w;
                }
    }
    for (int blk = wid; blk < 12; blk += 8) {
        const int h = blk / 3, part = blk % 3, n0 = blk * 32;
        const u16* W = (const u16*)(p.ws + OFF_WTUQ) + (size_t)l * 384 * 192;
        f32x16 acc[2];
#pragma unroll
        for (int i = 0; i < 2; ++i)
#pragma unroll
            for (int r = 0; r < 16; ++r) acc[i][r] = 0.f;
#pragma unroll
        for (int ks = 0; ks < 12; ++ks) {
            const bf16x8 bfr = *(const bf16x8*)(W + (size_t)(n0 + r32) * 192 + ks * 16 + hi * 8);
#pragma unroll
            for (int i = 0; i < 2; ++i) { const bf16x8 af = *(const bf16x8*)(Aq + (i * 32 + r32) * 200 + ks * 16 + hi * 8); acc[i] = MFMA32(bfr, af, acc[i]); }
        }
#pragma unroll
        for (int i = 0; i < 2; ++i) {
            const int m = i * 32 + r32;
            if (part == 2 && !isctx) {
                const float* rp = rope + ((size_t)(t0 + m) * 16 + 4 * hi) * 2;
#pragma unroll
                for (int a = 0; a < 2; ++a) {
                    const f32x4 cs0 = *(const f32x4*)(rp + a * 16), cs1 = *(const f32x4*)(rp + a * 16 + 4);
                    const float cc[4] = {cs0[0], cs0[2], cs1[0], cs1[2]}, ss[4] = {cs0[1], cs0[3], cs1[1], cs1[3]};
#pragma unroll
                    for (int k = 0; k < 4; ++k) { const float x1 = acc[i][8 * a + k], x2 = acc[i][8 * a + 4 + k];
                        acc[i][8 * a + k] = x1 * cc[k] - x2 * ss[k]; acc[i][8 * a + 4 + k] = x2 * cc[k] + x1 * ss[k]; }
                }
            }
#pragma unroll
            for (int r4 = 0; r4 < 4; ++r4) {
                u32x2 w; w.x = cvtpk(acc[i][4 * r4] * QSCALE, acc[i][4 * r4 + 1] * QSCALE); w.y = cvtpk(acc[i][4 * r4 + 2] * QSCALE, acc[i][4 * r4 + 3] * QSCALE);
                *(u32x2*)(Qg + ((size_t)(b * 4 + h) * SKV + s0 + m) * 96 + part * 32 + 8 * r4 + 4 * hi) = w;
            }
        }
    }
}

DI void unit_sgu(const Params& p, int l, int u, unsigned char* smem) {
    const int tid = otid(), wid = __builtin_amdgcn_readfirstlane(tid >> 6), lane = tid & 63, r32 = lane & 31, hi = lane >> 5;
    const u16* proj = (const u16*)(p.ws + OFF_PROJ); u16* mix = (u16*)(p.ws + OFF_H);
    u16* vnT = (u16*)smem;
    const int r0 = u * 128;
    __syncthreads();
    {
        const int s = tid >> 2, q = tid & 3; const u16* pr = proj + (size_t)(r0 + s) * NP + C_SV + q * 64;
        float xv[64]; float sum = 0.f;
#pragma unroll
        for (int i = 0; i < 8; ++i) { const u32x4 w = *(const u32x4*)(pr + i * 8);
            xv[i * 8 + 0] = bflo(w.x); xv[i * 8 + 1] = bfhi(w.x); xv[i * 8 + 2] = bflo(w.y); xv[i * 8 + 3] = bfhi(w.y);
            xv[i * 8 + 4] = bflo(w.z); xv[i * 8 + 5] = bfhi(w.z); xv[i * 8 + 6] = bflo(w.w); xv[i * 8 + 7] = bfhi(w.w); }
#pragma unroll
        for (int i = 0; i < 64; ++i) sum += xv[i];
        sum += __shfl_xor(sum, 1); sum += __shfl_xor(sum, 2);
        const float mean = sum * (1.f / 256.f);
        float qq = 0.f;
#pragma unroll
        for (int i = 0; i < 64; ++i) { const float d = xv[i] - mean; qq += d * d; }
        qq += __shfl_xor(qq, 1); qq += __shfl_xor(qq, 2);
        const float rstd = rsqrtf(qq * (1.f / 256.f) + LN_EPS);
        const float* gg = p.sgu_g + l * 256 + q * 64; const float* bb = p.sgu_b + l * 256 + q * 64;
#pragma unroll
        for (int i = 0; i < 64; ++i) vnT[(q * 64 + i) * 136 + s] = f2bf((xv[i] - mean) * rstd * gg[i] + bb[i]);
    }
    __syncthreads();
    {
        const int h = wid >> 1, c0 = h * 64 + (wid & 1) * 32;
        const u16* W = (const u16*)(p.ws + OFF_WS16) + (size_t)(l * 4 + h) * 128 * 128;
        f32x16 acc[4];
#pragma unroll
        for (int i = 0; i < 4; ++i)
#pragma unroll
            for (int r = 0; r < 16; ++r) acc[i][r] = 0.f;
#pragma unroll
        for (int ks = 0; ks < 8; ++ks) {
            const bf16x8 bfr = *(const bf16x8*)(vnT + (c0 + r32) * 136 + ks * 16 + hi * 8);
#pragma unroll
            for (int i = 0; i < 4; ++i) { const bf16x8 af = *(const bf16x8*)(W + (size_t)(i * 32 + r32) * 128 + ks * 16 + hi * 8); acc[i] = MFMA32(bfr, af, acc[i]); }
        }
#pragma unroll
        for (int i = 0; i < 4; ++i) {
            const int t = i * 32 + r32; const size_t row = (size_t)(r0 + t);
            const float bs = p.b_s[(l * 4 + h) * 128 + t];
#pragma unroll
            for (int r4 = 0; r4 < 4; ++r4) {
                const int c = c0 + 8 * r4 + 4 * hi;
                const u32x2 uw = *(const u32x2*)(proj + row * NP + C_SU + c), gw = *(const u32x2*)(proj + row * NP + C_G + 768 + c);
                const float o0 = bflo(uw.x) * (acc[i][4 * r4] + bs) * siluf_(bflo(gw.x)), o1 = bfhi(uw.x) * (acc[i][4 * r4 + 1] + bs) * siluf_(bfhi(gw.x));
                const float o2 = bflo(uw.y) * (acc[i][4 * r4 + 2] + bs) * siluf_(bflo(gw.y)), o3 = bfhi(uw.y) * (acc[i][4 * r4 + 3] + bs) * siluf_(bfhi(gw.y));
                u32x2 w; w.x = cvtpk(o0, o1); w.y = cvtpk(o2, o3);
                *(u32x2*)(mix + row * DM + 768 + c) = w;
            }
        }
    }
}

DI void unit_pool(const Params& p, int l, int u, unsigned char* smem) {
    const int tid = otid(), wid = __builtin_amdgcn_readfirstlane(tid >> 6), lane = tid & 63, r32 = lane & 31, hi = lane >> 5;
    const u16* proj = (const u16*)(p.ws + OFF_PROJ); u16* mix = (u16*)(p.ws + OFF_H);
    u16* halo = (u16*)smem;
    u16* At = (u16*)(smem + 80 * 512);
    const int r0 = u * 64; int b, t0, isctx; row_info(r0, b, t0, isctx);
    const int n = isctx ? CTXL : SEQ; const int rbase = r0 - t0;
    __syncthreads();
    for (int i = tid; i < 80 * 32; i += 512) {
        const int hr = i >> 5, ch = i & 31; const int t = t0 - 8 + hr;
        if (t >= 0 && t < n) *(u32x4*)(halo + hr * 256 + ch * 8) = *(const u32x4*)(proj + (size_t)(rbase + t) * NP + C_POOL + ch * 8);
    }
    __syncthreads();
    for (int it = tid; it < 64 * 32; it += 512) {
        const int m = it >> 5, cg = it & 31, gi = cg >> 3, w = 2 << gi; const int t = t0 + m;
        const int lo = max(t - (w >> 1), 0), hiw = min(t + w - (w >> 1), n);
        float s[8];
#pragma unroll
        for (int k = 0; k < 8; ++k) s[k] = 0.f;
        for (int tt = lo; tt < hiw; ++tt) {
            const u32x4 v = *(const u32x4*)(halo + (tt - t0 + 8) * 256 + cg * 8);
            s[0] += bflo(v.x); s[1] += bfhi(v.x); s[2] += bflo(v.y); s[3] += bfhi(v.y); s[4] += bflo(v.z); s[5] += bfhi(v.z); s[6] += bflo(v.w); s[7] += bfhi(v.w);
        }
        const float inv = 1.f / (float)(hiw - lo);
        const u32x4 c = *(const u32x4*)(halo + (m + 8) * 256 + cg * 8);
        u32x4 o;
        o.x = cvtpk(s[0] * inv - bflo(c.x), s[1] * inv - bfhi(c.x)); o.y = cvtpk(s[2] * inv - bflo(c.y), s[3] * inv - bfhi(c.y));
        o.z = cvtpk(s[4] * inv - bflo(c.z), s[5] * inv - bfhi(c.z)); o.w = cvtpk(s[6] * inv - bflo(c.w), s[7] * inv - bfhi(c.w));
        *(u32x4*)(At + m * 264 + cg * 8) = o;
    }
    __syncthreads();
    {
        const int gi = wid >> 1, d0 = (wid & 1) * 32;
        const u16* W = (const u16*)(p.ws + OFF_WTPOOL) + (size_t)(l * 4 + gi) * 64 * 64;
        f32x16 acc[2];
#pragma unroll
        for (int i = 0; i < 2; ++i)
#pragma unroll
            for (int r = 0; r < 16; ++r) acc[i][r] = 0.f;
#pragma unroll
        for (int ks = 0; ks < 4; ++ks) {
            const bf16x8 bfr = *(const bf16x8*)(W + (size_t)(d0 + r32) * 64 + ks * 16 + hi * 8);
#pragma unroll
            for (int i = 0; i < 2; ++i) { const bf16x8 af = *(const bf16x8*)(At + (i * 32 + r32) * 264 + gi * 64 + ks * 16 + hi * 8); acc[i] = MFMA32(bfr, af, acc[i]); }
        }
#pragma unroll
        for (int i = 0; i < 2; ++i) {
            const size_t row = (size_t)(r0 + i * 32 + r32);
#pragma unroll
            for (int r4 = 0; r4 < 4; ++r4) {
                const int c = gi * 64 + d0 + 8 * r4 + 4 * hi;
                const f32x4 ps = *(const f32x4*)(p.pool_scale + l * 256 + c);
                const u32x2 gw = *(const u32x2*)(proj + row * NP + C_G + 256 + c);
                u32x2 w; w.x = cvtpk(acc[i][4 * r4] * ps[0] * siluf_(bflo(gw.x)), acc[i][4 * r4 + 1] * ps[1] * siluf_(bfhi(gw.x)));
                w.y = cvtpk(acc[i][4 * r4 + 2] * ps[2] * siluf_(bflo(gw.y)), acc[i][4 * r4 + 3] * ps[3] * siluf_(bfhi(gw.y)));
                *(u32x2*)(mix + row * DM + 256 + c) = w;
            }
        }
    }
}

DI void s5_unit_rows(int u, int& r0, int& b, int& cidx) {
    if (u < 256) { r0 = u * 128; b = u >> 6; cidx = 2 + (u & 63); } else { const int uc = u - 256; r0 = NLAT + uc * 128; b = uc >> 1; cidx = uc & 1; }
}
DI int s5_rev_order(int i) { return i == 0 ? 1 : (i == 1 ? 0 : 67 - i); }

DI void s5_bu(const u16* proj, int tb, int g, int r32, int hi, const bf16x8 (&bR)[2], const bf16x8 (&bI)[2], unsigned* slab) {
    const bf16x8 ua = *(const bf16x8*)(proj + (size_t)(tb + r32) * NP + C_S5 + g * 16 + hi * 8);
    f32x16 z;
#pragma unroll
    for (int r = 0; r < 16; ++r) z[r] = 0.f;
    const f32x16 re0 = MFMA32(ua, bR[0], z), im0 = MFMA32(ua, bI[0], z), re1 = MFMA32(ua, bR[1], z), im1 = MFMA32(ua, bI[1], z);
#pragma unroll
    for (int r = 0; r < 16; ++r) { const int t = crow(r, hi); slab[t * 68 + r32] = cvtpk(re0[r], im0[r]); slab[t * 68 + 32 + r32] = cvtpk(re1[r], im1[r]); }
    asm volatile("" ::: "memory");
}

DI void unit_s5_pass1(const Params& p, int l, int u, unsigned char* smem) {
    const int tid = otid(), wid = __builtin_amdgcn_readfirstlane(tid >> 6), lane = tid & 63, r32 = lane & 31, hi = lane >> 5;
    const u16* proj = (const u16*)(p.ws + OFF_PROJ);
    unsigned* slab = (unsigned*)(smem + wid * 8704);
    int r0, b, cidx; s5_unit_rows(u, r0, b, cidx);
    float* E = (float*)(p.ws + OFF_E);
    __syncthreads();
    for (int gg = 0; gg < 2; ++gg) {
        const int g = wid * 2 + gg;
        for (int d = 0; d < 2; ++d) {
            const int pidx = ((l * 2 + d) * 16 + g) * 64;
            const float lr = ((const float*)(p.ws + OFF_LB))[(pidx + lane) * 2], li = ((const float*)(p.ws + OFF_LB))[(pidx + lane) * 2 + 1];
            bf16x8 bR[2], bI[2];
#pragma unroll
            for (int pb = 0; pb < 2; ++pb) { bR[pb] = *(const bf16x8*)((const u16*)(p.ws + OFF_BBR) + (size_t)(pidx + pb * 32 + r32) * 16 + hi * 8);
                bI[pb] = *(const bf16x8*)((const u16*)(p.ws + OFF_BBI) + (size_t)(pidx + pb * 32 + r32) * 16 + hi * 8); }
            float hr = 0.f, hi_ = 0.f;
            for (int sc = 0; sc < 4; ++sc) {
                const int scc = d ? 3 - sc : sc;
                s5_bu(proj, r0 + scc * 32, g, r32, hi, bR, bI, slab);
#pragma unroll 4
                for (int i = 0; i < 32; ++i) {
                    const int t = d ? 31 - i : i;
                    const unsigned w = slab[t * 68 + lane]; const float br = bflo(w), bi = bfhi(w);
                    const float nr = fmaf(lr, hr, fmaf(-li, hi_, br)), ni = fmaf(lr, hi_, fmaf(li, hr, bi));
                    hr = nr; hi_ = ni;
                }
                asm volatile("" ::: "memory");
            }
            float* ep = E + ((size_t)((d * 4 + b) * 66 + cidx) * 16 + g) * 128 + lane * 2;
            ep[0] = hr; ep[1] = hi_;
        }
    }
}

template <int D, int SC>
DI void s5_sub2(const u16* proj, int r0, int g, int lane, const bf16x8 (&bR)[2], const bf16x8 (&bI)[2], const bf16x8 (&cm)[4], float lr, float li, float& hr, float& hi_, unsigned* slab, f32x4 (&Y)[8]) {
    const int r32 = lane & 31, hi = lane >> 5;
    __builtin_amdgcn_sched_barrier(0);
    s5_bu(proj, r0 + SC * 32, g, r32, hi, bR, bI, slab);
    __builtin_amdgcn_sched_barrier(0);
#pragma unroll 4
    for (int i = 0; i < 32; ++i) {
        const int t = D ? 31 - i : i;
        const unsigned w = slab[t * 68 + lane]; const float br = bflo(w), bi = bfhi(w);
        const float nr = fmaf(lr, hr, fmaf(-li, hi_, br)), ni = fmaf(lr, hi_, fmaf(li, hr, bi));
        hr = nr; hi_ = ni;
        slab[t * 68 + lane] = cvtpk(hr, hi_);
    }
    asm volatile("" ::: "memory");
    const unsigned char* sb = (const unsigned char*)slab;
#pragma unroll
    for (int rb = 0; rb < 2; ++rb)
#pragma unroll
        for (int kb = 0; kb < 4; ++kb) {
            const bf16x8 a = *(const bf16x8*)(sb + (16 * rb + (lane & 15)) * 272 + kb * 64 + (lane >> 4) * 16);
            Y[2 * SC + rb] = MFMA16(a, cm[kb], Y[2 * SC + rb]);
        }
    asm volatile("" ::: "memory");
}

template <int D>
DI void s5_dir2(const Params& p, int l, int b, int cidx, int r0, int g, int lane, unsigned* slab, f32x4 (&Y)[8]) {
    const int r32 = lane & 31, hi = lane >> 5;
    const u16* proj = (const u16*)(p.ws + OFF_PROJ);
    const int pidx = ((l * 2 + D) * 16 + g) * 64;
    const float lr = ((const float*)(p.ws + OFF_LB))[(pidx + lane) * 2], li = ((const float*)(p.ws + OFF_LB))[(pidx + lane) * 2 + 1];
    bf16x8 bR[2], bI[2], cm[4];
#pragma unroll
    for (int pb = 0; pb < 2; ++pb) { bR[pb] = *(const bf16x8*)((const u16*)(p.ws + OFF_BBR) + (size_t)(pidx + pb * 32 + r32) * 16 + hi * 8);
        bI[pb] = *(const bf16x8*)((const u16*)(p.ws + OFF_BBI) + (size_t)(pidx + pb * 32 + r32) * 16 + hi * 8); }
#pragma unroll
    for (int kb = 0; kb < 4; ++kb) cm[kb] = *(const bf16x8*)((const u16*)(p.ws + OFF_CM) + ((size_t)(pidx >> 6) * 16 + (lane & 15)) * 128 + kb * 32 + (lane >> 4) * 8);
    float tr = lr, ti = li;
#pragma unroll
    for (int i = 0; i < 7; ++i) { const float a = tr * tr - ti * ti, c = 2.f * tr * ti; tr = a; ti = c; }
    const int pos = D ? (cidx == 1 ? 0 : (cidx == 0 ? 1 : 67 - cidx)) : cidx;
    const float* E = (const float*)(p.ws + OFF_E) + ((size_t)((D * 4 + b) * 66) * 16 + g) * 128 + lane * 2;
    float hr = 0.f, hi_ = 0.f;
    for (int i0 = 0; i0 < pos; i0 += 8) {
        float er[8], ei[8];
#pragma unroll
        for (int k = 0; k < 8; ++k) { const int ii = min(i0 + k, pos - 1); const int cj = D ? s5_rev_order(ii) : ii; const float* ep = E + (size_t)cj * 16 * 128; er[k] = ep[0]; ei[k] = ep[1]; }
#pragma unroll
        for (int k = 0; k < 8; ++k) if (i0 + k < pos) { const float nr = fmaf(tr, hr, fmaf(-ti, hi_, er[k])), ni = fmaf(tr, hi_, fmaf(ti, hr, ei[k])); hr = nr; hi_ = ni; }
    }
    if (D == 0) { s5_sub2<0, 0>(proj, r0, g, lane, bR, bI, cm, lr, li, hr, hi_, slab, Y); s5_sub2<0, 1>(proj, r0, g, lane, bR, bI, cm, lr, li, hr, hi_, slab, Y);
                  s5_sub2<0, 2>(proj, r0, g, lane, bR, bI, cm, lr, li, hr, hi_, slab, Y); s5_sub2<0, 3>(proj, r0, g, lane, bR, bI, cm, lr, li, hr, hi_, slab, Y); }
    else        { s5_sub2<1, 3>(proj, r0, g, lane, bR, bI, cm, lr, li, hr, hi_, slab, Y); s5_sub2<1, 2>(proj, r0, g, lane, bR, bI, cm, lr, li, hr, hi_, slab, Y);
                  s5_sub2<1, 1>(proj, r0, g, lane, bR, bI, cm, lr, li, hr, hi_, slab, Y); s5_sub2<1, 0>(proj, r0, g, lane, bR, bI, cm, lr, li, hr, hi_, slab, Y); }
}

DI void unit_s5_pass2(const Params& p, int l, int u, unsigned char* smem) {
    const int tid = otid(), wid = __builtin_amdgcn_readfirstlane(tid >> 6), lane = tid & 63, r32 = lane & 31, hi = lane >> 5;
    const u16* proj = (const u16*)(p.ws + OFF_PROJ); u16* mix = (u16*)(p.ws + OFF_H);
    unsigned* slab = (unsigned*)(smem + wid * 8704);
    u16* gy = (u16*)(smem + 8 * 8704);
    int r0, b, cidx; s5_unit_rows(u, r0, b, cidx);
    __syncthreads();
    for (int gg = 0; gg < 2; ++gg) {
        const int g = wid * 2 + gg;
        f32x4 Y[8];
#pragma unroll
        for (int i = 0; i < 8; ++i) Y[i] = (f32x4){0.f, 0.f, 0.f, 0.f};
        s5_dir2<0>(p, l, b, cidx, r0, g, lane, slab, Y);
        s5_dir2<1>(p, l, b, cidx, r0, g, lane, slab, Y);
        int lnb = lane; asm volatile("" : "+v"(lnb));
        const int c = g * 16 + (lnb & 15); const float dsk = p.s5_d[l * 256 + c];
#pragma unroll
        for (int i = 0; i < 8; ++i)
#pragma unroll
            for (int r = 0; r < 4; ++r) {
                const int t = 16 * i + (lnb >> 4) * 4 + r;
                const float y = Y[i][r] + bf2f(proj[(size_t)(r0 + t) * NP + C_S5 + c]) * dsk;
                gy[t * 264 + c] = f2bf(gelu_tanh(y));
            }
    }
    __syncthreads();
    {
        const int tid2 = otid(), r32 = tid2 & 31, hi = (tid2 >> 5) & 1;
        const int n0 = wid * 32;
        const u16* W = (const u16*)(p.ws + OFF_WTGLU) + (size_t)l * 256 * 256;
        f32x16 acc[4];
#pragma unroll
        for (int i = 0; i < 4; ++i)
#pragma unroll
            for (int r = 0; r < 16; ++r) acc[i][r] = 0.f;
#pragma unroll 4
        for (int ks = 0; ks < 16; ++ks) {
            const bf16x8 bfr = *(const bf16x8*)(W + (size_t)(n0 + r32) * 256 + ks * 16 + hi * 8);
#pragma unroll
            for (int i = 0; i < 4; ++i) { const bf16x8 af = *(const bf16x8*)(gy + (i * 32 + r32) * 264 + ks * 16 + hi * 8); acc[i] = MFMA32(bfr, af, acc[i]); }
        }
#pragma unroll
        for (int i = 0; i < 4; ++i) {
            const int t = i * 32 + r32; const size_t row = (size_t)(r0 + t);
#pragma unroll
            for (int r4 = 0; r4 < 4; ++r4) {
                const int n = n0 + 8 * r4 + 4 * hi;
                const f32x4 bg = *(const f32x4*)(p.b_glu + l * 256 + n);
                const u32x2 yw = *(const u32x2*)(gy + t * 264 + n), gw = *(const u32x2*)(proj + row * NP + C_G + 512 + n);
                const float o0 = bflo(yw.x) * sigmoidf_(acc[i][4 * r4] + bg[0]) * siluf_(bflo(gw.x)), o1 = bfhi(yw.x) * sigmoidf_(acc[i][4 * r4 + 1] + bg[1]) * siluf_(bfhi(gw.x));
                const float o2 = bflo(yw.y) * sigmoidf_(acc[i][4 * r4 + 2] + bg[2]) * siluf_(bflo(gw.y)), o3 = bfhi(yw.y) * sigmoidf_(acc[i][4 * r4 + 3] + bg[3]) * siluf_(bfhi(gw.y));
                u32x2 w; w.x = cvtpk(o0, o1); w.y = cvtpk(o2, o3);
                *(u32x2*)(mix + row * DM + 512 + n) = w;
            }
        }
    }
}

constexpr int AT_V = 64 * 64 * 2, AT_K = 64 * 256, AT_LDS = 2 * AT_V + 2 * AT_K + 8 * 64 * 4;
constexpr float AT_THR = 11.5f;
#define KSWZ(row, colB) ((row) * 256 + ((colB) ^ (((row) & 7) << 4)))
#define SBAR() __builtin_amdgcn_sched_barrier(0)
DI void partialSM(f32x16& p0, f32x16& p1, float& m_reg, float& mn, float& alpha) {
    float pmax = p0[0];
#pragma unroll
    for (int r = 1; r < 16; ++r) pmax = fmaxf(pmax, p0[r]);
#pragma unroll
    for (int r = 0; r < 16; ++r) pmax = fmaxf(pmax, p1[r]);
    { auto rr = __builtin_amdgcn_permlane32_swap(__float_as_uint(pmax), __float_as_uint(pmax), false, false);
      pmax = fmaxf(__uint_as_float(rr[0]), __uint_as_float(rr[1])); }
    if (__builtin_expect(__all(pmax - m_reg <= AT_THR), 1)) { mn = m_reg; alpha = 1.f; }
    else { mn = fmaxf(m_reg, pmax); alpha = fexp2(m_reg - mn); m_reg = mn; }
#pragma unroll
    for (int r = 0; r < 16; ++r) p0[r] = p0[r] - mn;
#pragma unroll
    for (int r = 0; r < 16; ++r) p1[r] = p1[r] - mn;
#pragma unroll
    for (int r = 0; r < 16; ++r) p0[r] = fexp2(p0[r]);
}
DI void finishSM(f32x16& p0, f32x16& p1, float alpha, float& l_reg, bf16x8& pa0, bf16x8& pa1, bf16x8& pa2, bf16x8& pa3) {
#pragma unroll
    for (int r = 0; r < 16; ++r) p1[r] = fexp2(p1[r]);
    float ps = 0;
#pragma unroll
    for (int r = 0; r < 16; ++r) ps += p0[r];
#pragma unroll
    for (int r = 0; r < 16; ++r) ps += p1[r];
    { auto rr = __builtin_amdgcn_permlane32_swap(__float_as_uint(ps), __float_as_uint(ps), false, false);
      ps = __uint_as_float(rr[0]) + __uint_as_float(rr[1]); }
    l_reg = l_reg * alpha + ps;
#define PK4(P, BASE, OUT) do { unsigned a0 = cvtpk(P[BASE + 0], P[BASE + 1]), a1 = cvtpk(P[BASE + 2], P[BASE + 3]);   \
    unsigned b0 = cvtpk(P[BASE + 4], P[BASE + 5]), b1 = cvtpk(P[BASE + 6], P[BASE + 7]);                              \
    auto r0 = __builtin_amdgcn_permlane32_swap(a0, b0, false, false); auto r1 = __builtin_amdgcn_permlane32_swap(a1, b1, false, false); \
    u32x4 w = {r0[0], r1[0], r0[1], r1[1]}; OUT = *reinterpret_cast<bf16x8*>(&w); } while (0)
    PK4(p0, 0, pa0); PK4(p0, 8, pa1); PK4(p1, 0, pa2); PK4(p1, 8, pa3);
#undef PK4
}
DI void qkt(f32x16& p0, f32x16& p1, const unsigned char* Ks, const bf16x8* qr, int r32, int hi) {
#pragma unroll
    for (int r = 0; r < 16; ++r) { p0[r] = 0.f; p1[r] = 0.f; }
#pragma unroll
    for (int d0 = 0; d0 < 6; ++d0) { const int cb = (d0 * 16 + hi * 8) * 2;
        const bf16x8 b0 = *reinterpret_cast<const bf16x8*>(Ks + KSWZ(r32, cb));
        const bf16x8 b1 = *reinterpret_cast<const bf16x8*>(Ks + KSWZ(32 + r32, cb));
        p0 = MFMA32(b0, qr[d0], p0);
        p1 = MFMA32(b1, qr[d0], p1); }
}
DI int v_st(int k, int c) { const int kk = (k & ~0xC) | ((k & 4) << 1) | ((k & 8) >> 1); return ((kk >> 3) * 2 + (c >> 5)) * 512 + ((kk & 7) * 32 + (c & 31)) * 2; }
DI int v_rd_base(int lane) { return ((lane & 3) << 3) | (((lane >> 2) & 3) << 6) | (((lane >> 4) & 1) << 5) | (((lane >> 5) & 1) << 8); }
constexpr int v_rd_off(int d0, int ks, int half) { return d0 * 512 + ks * 2048 + half * 1024; }
template <int OFF> DI s16x4 tr_read(int vb) { s16x4 r; asm volatile("ds_read_b64_tr_b16 %0, %1 offset:%2" : "=&v"(r) : "v"(vb), "i"(OFF) : "memory"); return r; }
template <int D0> DI void pv_one(f32x16& od, int vb, bf16x8 pa0, bf16x8 pa1, bf16x8 pa2, bf16x8 pa3) {
    const s16x4 l0 = tr_read<v_rd_off(D0, 0, 0)>(vb), h0 = tr_read<v_rd_off(D0, 0, 1)>(vb), l1 = tr_read<v_rd_off(D0, 1, 0)>(vb), h1 = tr_read<v_rd_off(D0, 1, 1)>(vb);
    const s16x4 l2 = tr_read<v_rd_off(D0, 2, 0)>(vb), h2 = tr_read<v_rd_off(D0, 2, 1)>(vb), l3 = tr_read<v_rd_off(D0, 3, 0)>(vb), h3 = tr_read<v_rd_off(D0, 3, 1)>(vb);
    asm volatile("s_waitcnt lgkmcnt(0)" ::: "memory"); SBAR();
#define PK(L, H) (bf16x8){L[0], L[1], L[2], L[3], H[0], H[1], H[2], H[3]}
    od = MFMA32(pa0, PK(l0, h0), od);
    od = MFMA32(pa1, PK(l1, h1), od);
    od = MFMA32(pa2, PK(l2, h2), od);
    od = MFMA32(pa3, PK(l3, h3), od);
#undef PK
}
DI void pv_d0(f32x16* o, int vb, bf16x8 pa0, bf16x8 pa1, bf16x8 pa2, bf16x8 pa3) { pv_one<0>(o[0], vb, pa0, pa1, pa2, pa3); pv_one<1>(o[1], vb, pa0, pa1, pa2, pa3); }

DI void attn_unit(const u16* __restrict__ Qb, const u16* __restrict__ Kh, const u16* __restrict__ Vh, int nkeys, int row0, int h, const Params& p, unsigned char* lds) {
    const int tid = otid(), wid = __builtin_amdgcn_readfirstlane(tid >> 6), lane = tid & 63, r32 = lane & 31, hi = lane >> 5;
    unsigned char* V_lds = lds; unsigned char* K_lds = lds + 2 * AT_V;
    float* wsl = (float*)(lds + 2 * AT_V + 2 * AT_K) + wid * 64; float* li_l = wsl; float* al_l = wsl + 32;
    float m_reg = -1e30f, l_reg = 0; f32x16 o[2]; bf16x8 qr[6];
#pragma unroll
    for (int d = 0; d < 2; ++d)
#pragma unroll
        for (int r = 0; r < 16; ++r) o[d][r] = 0.f;
    const u16* Qw = Qb + (size_t)(wid * 32 + r32) * 96 + hi * 8;
#pragma unroll
    for (int d0 = 0; d0 < 6; ++d0) qr[d0] = *(const bf16x8*)(Qw + d0 * 16);
    const int vst = v_st(tid >> 3, (tid & 7) * 8);
    const int kc0 = tid, kc1 = 512 + (tid & 255);
    const int kst0 = KSWZ(kc0 / 12, (kc0 % 12) * 16), kst1 = KSWZ(kc1 / 12, (kc1 % 12) * 16);
    const bool k2 = tid < 256;
    const int vb0 = (int)(uintptr_t)V_lds + v_rd_base(lane);
    struct { bf16x8 vs, ks0, ks1; } sr_[2];
#define SLOAD(i, k0) do { sr_[i].vs = *(const bf16x8*)(Vh + (size_t)(k0) * 64 + tid * 8); sr_[i].ks0 = *(const bf16x8*)(Kh + (size_t)(k0) * 96 + kc0 * 8); \
    sr_[i].ks1 = *(const bf16x8*)(Kh + (size_t)(k0) * 96 + kc1 * 8); } while (0)
#define SWRITE(b, i) do { *(bf16x8*)(V_lds + (b) * AT_V + vst) = sr_[i].vs; *(bf16x8*)(K_lds + (b) * AT_K + kst0) = sr_[i].ks0; \
    if (k2) *(bf16x8*)(K_lds + (b) * AT_K + kst1) = sr_[i].ks1; } while (0)
#define SWAIT() asm volatile("s_waitcnt vmcnt(3)" ::: "memory")
#define RESC(a) do { if (__any((a) < 1.f)) { if (hi == 0) al_l[r32] = (a); asm volatile("s_waitcnt lgkmcnt(0)" ::: "memory"); \
    _Pragma("unroll") for (int d = 0; d < 2; ++d) _Pragma("unroll") for (int r = 0; r < 16; ++r) o[d][r] *= al_l[crow(r, hi)]; } } while (0)
    f32x16 pA0, pA1, pB0, pB1; float mnA, mnB, alA, alB; bf16x8 pa0, pa1, pa2, pa3; const int NT = nkeys / 64;
    constexpr int SE = 0, SO = 1;
    __syncthreads();
    SLOAD(SE, 0); asm volatile("s_waitcnt vmcnt(0)" ::: "memory"); SWRITE(0, SE); __syncthreads();
    qkt(pA0, pA1, K_lds, qr, r32, hi); partialSM(pA0, pA1, m_reg, mnA, alA);
    SLOAD(SO, 64); if (2 < NT) SLOAD(SE, 128);
    SWAIT(); SWRITE(1, SO); __syncthreads();
    for (int j = 1; j + 1 < NT; j += 2) {
        SBAR(); qkt(pB0, pB1, K_lds + AT_K, qr, r32, hi);
        finishSM(pA0, pA1, alA, l_reg, pa0, pa1, pa2, pa3); SBAR();
        SLOAD(SO, (j + 2) * 64); SBAR();
        pv_d0(o, vb0, pa0, pa1, pa2, pa3); partialSM(pB0, pB1, m_reg, mnB, alB);
        __syncthreads(); SWAIT(); SWRITE(0, SE);
        RESC(alB); __syncthreads();
        SBAR(); qkt(pA0, pA1, K_lds, qr, r32, hi);
        finishSM(pB0, pB1, alB, l_reg, pa0, pa1, pa2, pa3); SBAR();
        if (j + 3 < NT) SLOAD(SE, (j + 3) * 64); SBAR();
        pv_d0(o, vb0 + AT_V, pa0, pa1, pa2, pa3); partialSM(pA0, pA1, m_reg, mnA, alA);
        __syncthreads(); SWAIT(); SWRITE(1, SO);
        RESC(alA); __syncthreads();
    }
    SBAR(); qkt(pB0, pB1, K_lds + AT_K, qr, r32, hi);
    finishSM(pA0, pA1, alA, l_reg, pa0, pa1, pa2, pa3); SBAR();
    pv_d0(o, vb0, pa0, pa1, pa2, pa3); partialSM(pB0, pB1, m_reg, mnB, alB);
    __syncthreads(); RESC(alB);
    finishSM(pB0, pB1, alB, l_reg, pa0, pa1, pa2, pa3); SBAR();
    pv_d0(o, vb0 + AT_V, pa0, pa1, pa2, pa3);
    if (hi == 0) li_l[r32] = l_reg; asm volatile("s_waitcnt lgkmcnt(0)" ::: "memory");
    const u16* proj = (const u16*)(p.ws + OFF_PROJ); u16* mix = (u16*)(p.ws + OFF_H);
#pragma unroll
    for (int r = 0; r < 16; ++r) {
        const int orow = row0 + wid * 32 + crow(r, hi); const float rl = __builtin_amdgcn_rcpf(li_l[crow(r, hi)]);
#pragma unroll
        for (int d0 = 0; d0 < 2; ++d0) {
            const int c = h * 64 + d0 * 32 + r32;
            const float gt = bf2f(proj[(size_t)orow * NP + C_G + c]);
            mix[(size_t)orow * DM + c] = f2bf(o[d0][r] * rl * siluf_(gt));
        }
    }
#undef SLOAD
#undef SWRITE
#undef SWAIT
#undef RESC
}

DI void phase_c(const Params& p, int l, unsigned char* smem) {
    const int last = (l == 1);
    const int n_s5 = 264, n_sgu = last ? 256 : 264, n_mla = 528, n_pool = last ? 512 : 528;
    const int total = n_s5 + n_sgu + n_mla + n_pool;
    for (int u = blockIdx.x; u < total; u += gridDim.x) {
        int v = u;
        if (v < n_s5) { unit_s5_pass1(p, l, v, smem); continue; }
        v -= n_s5;
        if (v < n_sgu) { unit_sgu(p, l, v, smem); continue; }
        v -= n_sgu;
        if (v < n_mla) { unit_mla(p, l, v, smem); continue; }
        v -= n_mla;
        unit_pool(p, l, v, smem);
    }
}

DI void phase_d(const Params& p, int l, unsigned char* smem) {
    const int last = (l == 1);
    const int n_att = last ? 512 : 528, n_s5 = last ? 256 : 264;
    const u16* Qg = (const u16*)(p.ws + OFF_Q); const u16* Kg = (const u16*)(p.ws + OFF_K); const u16* Vg = (const u16*)(p.ws + OFF_V);
    for (int u = blockIdx.x; u < n_att + n_s5; u += gridDim.x) {
        if (u < 512) {
            const int bh = (u & 7) + 8 * (u >> 8), qb = (u >> 3) & 31, b = bh >> 2, h = bh & 3;
            attn_unit(Qg + ((size_t)bh * SKV + 256 + qb * 256) * 96, Kg + (size_t)bh * SKV * 96, Vg + (size_t)bh * SKV * 64, SKV, b * SEQ + qb * 256, h, p, smem);
        } else if (u < n_att) {
            const int bh = u - 512, b = bh >> 2, h = bh & 3;
            attn_unit(Qg + (size_t)bh * SKV * 96, Kg + (size_t)bh * SKV * 96, Vg + (size_t)bh * SKV * 64, CTXL, NLAT + b * CTXL, h, p, smem);
        } else {
            unit_s5_pass2(p, l, u - n_att, smem);
        }
    }
}

DI void gsync(cg::grid_group& g) {
    asm volatile("s_waitcnt vmcnt(0) lgkmcnt(0)" ::: "memory");
    g.sync();
    asm volatile("buffer_inv sc1\n\ts_waitcnt vmcnt(0)" ::: "memory");
}
__global__ void __launch_bounds__(512) fwd_megakernel(Params p) {
    extern __shared__ __attribute__((aligned(16))) unsigned char smem[];
    cg::grid_group grid = cg::this_grid();
    u16* hb = (u16*)(p.ws + OFF_H); u16* proj = (u16*)(p.ws + OFF_PROJ); u16* yb = (u16*)(p.ws + OFF_Y);
    phase_w(p, smem);
    gsync(grid);
    phase_a(p, smem);
    gsync(grid);
    for (int l = 0; l < 2; ++l) {
        phase_gemm(hb, (const u16*)(p.ws + OFF_WTIN) + (size_t)l * NP * DM, proj, NTOK, NP, NP, smem);
        gsync(grid);
        phase_c(p, l, smem);
        gsync(grid);
        phase_d(p, l, smem);
        gsync(grid);
        phase_gemm(hb, (const u16*)(p.ws + OFF_WTOUT) + (size_t)l * DM * DM, yb, l ? NLAT : NTOK, DM, DM, smem);
        gsync(grid);
        phase_f(p, l, smem);
        if (l == 0) gsync(grid);
    }
}

extern "C" void kernel_launch(void* const* d_in, const int* in_sizes, int n_in, void* d_out, int out_size, void* d_ws, size_t ws_size, hipStream_t stream) {
    static int grid_blocks = 0;
    if (grid_blocks == 0) {
        if (n_in != 30 || out_size != NLAT * DM || ws_size < WS_END) { fprintf(stderr, "kernel_launch: unexpected shapes (n_in %d out %d ws %zu need %zu)\n", n_in, out_size, ws_size, (size_t)WS_END); grid_blocks = -1; return; }
        int dev = 0, cus = 0, per_cu = 0;
        hipGetDevice(&dev);
        hipDeviceGetAttribute(&cus, hipDeviceAttributeMultiprocessorCount, dev);
        if (hipFuncSetAttribute((const void*)fwd_megakernel, hipFuncAttributeMaxDynamicSharedMemorySize, LDS_BYTES) != hipSuccess) { fprintf(stderr, "kernel_launch: hipFuncSetAttribute failed\n"); grid_blocks = -1; return; }
        hipOccupancyMaxActiveBlocksPerMultiprocessor(&per_cu, (const void*)fwd_megakernel, 512, LDS_BYTES);
        if (per_cu < 1) { fprintf(stderr, "kernel_launch: occupancy query says %d blocks per CU\n", per_cu); per_cu = 1; }
        grid_blocks = cus * per_cu;
    }
    if (grid_blocks < 0) return;
    Params p{};
    const float** pp = (const float**)&p;
    for (int i = 0; i < 30; ++i) pp[i] = (const float*)d_in[i];
    p.out = (float*)d_out; p.ws = (unsigned char*)d_ws;
    void* args[] = {&p};
    hipError_t e = hipLaunchCooperativeKernel((const void*)fwd_megakernel, dim3(grid_blocks), dim3(512), args, LDS_BYTES, stream);
    if (e != hipSuccess) fprintf(stderr, "cooperative launch failed: %s (grid %d)\n", hipGetErrorString(e), grid_blocks);
}
```

```cpp
#include <hip/hip_runtime.h>
#include <hip/hip_cooperative_groups.h>
#include <cstdio>
#include <cstdint>
namespace cg = cooperative_groups;
namespace pg8 {
#define PG8_LAS __attribute__((address_space(3)))
typedef unsigned short bf16_t;
typedef short bf16x8 __attribute__((ext_vector_type(8)));
typedef float f32x4 __attribute__((ext_vector_type(4)));
typedef unsigned u32x4 __attribute__((ext_vector_type(4)));
constexpr int BM = 256, BK = 64, HALF = 128, HTB = HALF * BK * 2  , STAGE_BYTES = 8 * HTB, NXCD = 8, WGM = 8;

__host__ __device__ __forceinline__ int lds_byte(int r, int c) { const int st = (r >> 4) * 2 + (c >> 5), rr = r & 15, cc = c & 31, ob = rr * 64 + cc * 2; return st * 1024 + (ob ^ (((ob >> 9) & 1) << 5)); }
__host__ __device__ __forceinline__ void stage_rc(int b, int& R, int& C) { const int st = b / 1024, sb = b % 1024, swz = sb ^ (((sb >> 9) & 1) << 5); R = (st >> 1) * 16 + swz / 64; C = (st & 1) * 32 + (swz % 64) / 2; }
__host__ __device__ __forceinline__ int perm32(int rho) { const int n = rho >> 4, i = rho & 15; return 8 * (i >> 2) + 4 * n + (i & 3); }

struct Unit { int pm, pn; };
struct Gemm { const bf16_t* A; const bf16_t* Bt; int M, N, K; };

struct StaticOrder {
    int nM, nN, nwg, G, c;
    __host__ __device__ void init(int M, int N, int G_, int c_) { nM = M / BM; nN = N / BM; nwg = nM * nN; G = G_; c = c_; }
    __host__ __device__ bool next(int i, Unit& u) const {
        const long L = (long)i * G + c; if (L >= nwg) return false;
        int wgid = (int)L; { const int q = nwg / NXCD, r = nwg % NXCD, xcd = wgid % NXCD, off = wgid / NXCD; wgid = (xcd < r ? xcd * (q + 1) : r * (q + 1) + (xcd - r) * q) + off; }
        const int nig = WGM * nN, gid = wgid / nig, fm = gid * WGM, gsz = (nM - fm) < WGM ? (nM - fm) : WGM;
        u.pm = fm + ((wgid % nig) % gsz); u.pn = (wgid % nig) / gsz; return true;
    }
    __device__ __forceinline__ void a_ready(const Unit&) const {}
    __device__ __forceinline__ void done(const Unit&) const {}
};
typedef float f32x2v __attribute__((ext_vector_type(2))); typedef __bf16 bf16x2v __attribute__((ext_vector_type(2)));
__device__ __forceinline__ unsigned cvt_pk_bf16(float lo, float hi) { const f32x2v v = {lo, hi}; const bf16x2v b = __builtin_convertvector(v, bf16x2v); return __builtin_bit_cast(unsigned, b); }
template <class Epi, class Sched, bool STAMP = false>
__device__ __forceinline__ void gemm_phase(PG8_LAS unsigned char* lds, const Gemm g, const Sched& S, const Epi& E, unsigned long long* stamps) {
    int tid = threadIdx.x; asm volatile("" : "+v"(tid)); const int wid = __builtin_amdgcn_readfirstlane(tid >> 6), lane = tid & 63, wr = wid >> 2, wc = wid & 3, fr = lane & 15, fq = lane >> 4;
    const int K = g.K, nt = K / BK;
    int ts_lo = 0, ts_hi = 0, nts = 0; const unsigned long long rt_entry = STAMP ? (unsigned long long)wall_clock64() : 0ull;
#define PG8_STAMP() do { if (STAMP && wid == 0 && nts < 64) { const unsigned long long _c = (unsigned long long)clock64(); \
        ts_lo = (lane == nts) ? (int)(unsigned)_c : ts_lo; ts_hi = (lane == nts) ? (int)(unsigned)(_c >> 32) : ts_hi; ++nts; } } while (0)
    PG8_STAMP();
    unsigned voffA[2], voffB[2];
#pragma unroll
    for (int i = 0; i < 2; ++i) { int R, C; stage_rc(tid * 16 + i * 8192, R, C); const int Rb = Epi::PERM ? ((R & ~31) + perm32(R & 31)) : R;
        voffA[i] = (unsigned)(R * K + C) * 2u; voffB[i] = (unsigned)(Rb * K + C) * 2u; }
    const size_t kstep = (size_t)(BK * 2);
    const size_t hstep = (size_t)HALF * K * 2;
    const size_t tstep = 2 * hstep;
    const unsigned ldsw = (unsigned)wid * 1024u;
    const int aoff = lds_byte(wr * 64 + fr, fq * 8), boff = lds_byte(wc * 32 + fr, fq * 8);
#define PG8_SA(b, h) (((b) * 2 + (h)) * HTB)
#define PG8_SB(b, h) ((4 + (b) * 2 + (h)) * HTB)
#define PG8_STAGE(bufoff, gbase, voff) do { _Pragma("unroll") for (int _i = 0; _i < 2; ++_i) \
        __builtin_amdgcn_global_load_lds((const unsigned*)((const char*)(gbase) + (voff)[_i]), (PG8_LAS unsigned*)(lds + (bufoff) + ldsw + _i * 8192), 16, 0, 0); } while (0)
#define PG8_LDA(dst, b, h) do { _Pragma("unroll") for (int m = 0; m < 4; ++m) _Pragma("unroll") for (int k = 0; k < 2; ++k) dst[m][k] = *(const PG8_LAS bf16x8*)(lds + PG8_SA(b, h) + aoff + m * 2048 + k * 1024); } while (0)
#define PG8_LDB(dst, b, h) do { _Pragma("unroll") for (int n = 0; n < 2; ++n) _Pragma("unroll") for (int k = 0; k < 2; ++k) dst[n][k] = *(const PG8_LAS bf16x8*)(lds + PG8_SB(b, h) + boff + n * 2048 + k * 1024); } while (0)
#define PG8_MMA(ai, bj, At, Bt) do { __builtin_amdgcn_s_setprio(1); _Pragma("unroll") for (int m = 0; m < 4; ++m) _Pragma("unroll") for (int n = 0; n < 2; ++n) _Pragma("unroll") for (int k = 0; k < 2; ++k) \
        acc[ai][bj][m][n] = __builtin_amdgcn_mfma_f32_16x16x32_bf16(Bt[n][k], At[m][k], acc[ai][bj][m][n], 0, 0, 0); __builtin_amdgcn_s_setprio(0); } while (0)
#define PG8_WAIT_V(n) asm volatile("s_waitcnt vmcnt(" #n ")" ::: "memory")
#define PG8_WAIT_L(n) asm volatile("s_waitcnt lgkmcnt(" #n ")" ::: "memory")
#define PG8_BAR __builtin_amdgcn_s_barrier()
#define PG8_SCHED __builtin_amdgcn_sched_barrier(0)
    Unit cur, nxt; int ui = 0;
    if (!S.next(0, cur)) return;
    f32x4 acc[2][2][4][2];
#pragma unroll
    for (int a = 0; a < 2; ++a)
#pragma unroll
        for (int b = 0; b < 2; ++b)
#pragma unroll
            for (int m = 0; m < 4; ++m)
#pragma unroll
                for (int n = 0; n < 2; ++n) acc[a][b][m][n] = (f32x4){0.f, 0.f, 0.f, 0.f};
    bf16x8 At[4][2], B0[2][2], B1[2][2];
    const char* cA = (const char*)g.A + (size_t)cur.pm * tstep; const char* cB = (const char*)g.Bt + (size_t)cur.pn * tstep;
    S.a_ready(cur);
    PG8_STAGE(PG8_SB(0, 0), cB, voffB); PG8_STAGE(PG8_SA(0, 0), cA, voffA); PG8_STAGE(PG8_SB(0, 1), cB + hstep, voffB); PG8_STAGE(PG8_SA(0, 1), cA + hstep, voffA);
    if (wr == 1) PG8_BAR;
    PG8_WAIT_V(4); PG8_BAR;
    PG8_STAGE(PG8_SB(1, 0), cB + kstep, voffB); PG8_STAGE(PG8_SA(1, 0), cA + kstep, voffA); PG8_STAGE(PG8_SB(1, 1), cB + hstep + kstep, voffB);
    PG8_WAIT_V(6); PG8_BAR;
    PG8_STAMP();
    for (;;) {
        const bool has_next = S.next(ui + 1, nxt);
        const char* nA = has_next ? (const char*)g.A + (size_t)nxt.pm * tstep : cA; const char* nB = has_next ? (const char*)g.Bt + (size_t)nxt.pn * tstep : cB;
        for (int t = 0; t < nt; t += 2) {
            const bool last = (t == nt - 2);
            const char* a1 = cA + (size_t)(t + 1) * kstep;
            const char* a2 = last ? nA : cA + (size_t)(t + 2) * kstep; const char* b2 = last ? nB : cB + (size_t)(t + 2) * kstep;
            const char* a3 = a2 + kstep; const char* b3 = b2 + kstep;
            if (last && has_next) S.a_ready(nxt);
            PG8_LDB(B0, 0, 0); PG8_SCHED; PG8_LDA(At, 0, 0); PG8_STAGE(PG8_SA(1, 1), a1 + hstep, voffA);
            PG8_WAIT_L(8); PG8_BAR; PG8_WAIT_L(0); PG8_MMA(0, 0, At, B0); PG8_BAR; PG8_SCHED;
            PG8_LDB(B1, 0, 1); PG8_STAGE(PG8_SB(0, 0), b2, voffB);
            PG8_BAR; PG8_WAIT_L(0); PG8_MMA(0, 1, At, B1); PG8_BAR;
            PG8_LDA(At, 0, 1); PG8_STAGE(PG8_SA(0, 0), a2, voffA);
            PG8_BAR; PG8_WAIT_L(0); PG8_MMA(1, 0, At, B0); PG8_BAR; PG8_SCHED;
            PG8_STAGE(PG8_SB(0, 1), b2 + hstep, voffB);
            PG8_WAIT_V(6); PG8_BAR; PG8_MMA(1, 1, At, B1); PG8_BAR;
            PG8_LDB(B0, 1, 0); PG8_SCHED; PG8_LDA(At, 1, 0); PG8_STAGE(PG8_SA(0, 1), a2 + hstep, voffA);
            PG8_WAIT_L(8); PG8_BAR; PG8_WAIT_L(0); PG8_MMA(0, 0, At, B0); PG8_BAR; PG8_SCHED;
            PG8_LDB(B1, 1, 1); PG8_STAGE(PG8_SB(1, 0), b3, voffB);
            PG8_BAR; PG8_WAIT_L(0); PG8_MMA(0, 1, At, B1); PG8_BAR;
            PG8_LDA(At, 1, 1); PG8_STAGE(PG8_SA(1, 0), a3, voffA);
            PG8_BAR; PG8_WAIT_L(0); PG8_MMA(1, 0, At, B0); PG8_BAR; PG8_SCHED;
            PG8_STAGE(PG8_SB(1, 1), b3 + hstep, voffB);
            PG8_WAIT_V(6); PG8_BAR; PG8_MMA(1, 1, At, B1); PG8_BAR;
        }
        PG8_STAMP();
        if constexpr (!Epi::AFTER_DRAIN) { E(acc, cur, wr, wc, fr, fq); S.done(cur); }
        PG8_STAMP();
        if (!has_next) break;
#pragma unroll
        for (int a = 0; a < 2; ++a)
#pragma unroll
            for (int b = 0; b < 2; ++b)
#pragma unroll
                for (int m = 0; m < 4; ++m)
#pragma unroll
                    for (int n = 0; n < 2; ++n) acc[a][b][m][n] = (f32x4){0.f, 0.f, 0.f, 0.f};
        cur = nxt; cA = nA; cB = nB; ++ui;
    }
    PG8_WAIT_V(0);
    if (wr == 0) PG8_BAR;
    PG8_BAR;
    if constexpr (Epi::AFTER_DRAIN) { E.fused(acc, cur, wr, wc, fr, fq, lds, wid, lane); S.done(cur); }
    PG8_STAMP();
    if (STAMP && wid == 0) { stamps[lane] = lane < nts ? (((unsigned long long)(unsigned)ts_hi << 32) | (unsigned)ts_lo) : 0ull;
        if (lane == 62) stamps[62] = rt_entry; if (lane == 63) stamps[63] = (unsigned long long)wall_clock64(); }
#undef PG8_STAMP
#undef PG8_SA
#undef PG8_SB
#undef PG8_STAGE
#undef PG8_LDA
#undef PG8_LDB
#undef PG8_MMA
#undef PG8_WAIT_V
#undef PG8_WAIT_L
#undef PG8_BAR
#undef PG8_SCHED
}
}
namespace pg8 {
struct EpiStoreBf16 {
    static constexpr bool PERM = true, AFTER_DRAIN = false;
    bf16_t* O; int ldc;
    __device__ __forceinline__ void operator()(const f32x4 (&acc)[2][2][4][2], const Unit& u, int wr, int wc, int fr, int fq) const {
        const int row0 = u.pm * BM + wr * 64 + fr; const int col0 = u.pn * BM + wc * 32 + 8 * fq;
#pragma unroll
        for (int ai = 0; ai < 2; ++ai)
#pragma unroll
            for (int m = 0; m < 4; ++m) { bf16_t* rowp = O + (size_t)(row0 + ai * HALF + m * 16) * ldc + col0;
#pragma unroll
                for (int bj = 0; bj < 2; ++bj) { const f32x4 v0 = acc[ai][bj][m][0], v1 = acc[ai][bj][m][1];
                    u32x4 w; w.x = cvt_pk_bf16(v0[0], v0[1]); w.y = cvt_pk_bf16(v0[2], v0[3]); w.z = cvt_pk_bf16(v1[0], v1[1]); w.w = cvt_pk_bf16(v1[2], v1[3]);
                    *(u32x4*)(rowp + bj * HALF) = w; } }
    }
};
}

#define DI __device__ __forceinline__
typedef unsigned short u16;
typedef short bf16x8 __attribute__((ext_vector_type(8)));
typedef short s16x4 __attribute__((ext_vector_type(4)));
typedef float f32x4 __attribute__((ext_vector_type(4)));
typedef float f32x16 __attribute__((ext_vector_type(16)));
typedef unsigned u32x4 __attribute__((ext_vector_type(4)));
typedef unsigned u32x2 __attribute__((ext_vector_type(2)));

constexpr int NLAT = 32768, NCTX = 1024, NTOK = 33792, DM = 1024, NP = 2560, SEQ = 8192, CTXL = 256, SKV = 8448, NIN = 2400;
constexpr int C_CKV = 0, C_KR = 128, C_S5 = 160, C_CQ = 416, C_POOL = 608, C_SU = 864, C_SV = 1120, C_G = 1376;
constexpr float LN_EPS = 1e-6f, ALPHA = 1.4142135623730951f;
constexpr float QSCALE = 0.10206207261596575f * 1.4426950408889634f;
constexpr int KSPLIT = 8;

constexpr size_t OFF_WTIN = 0;
constexpr size_t OFF_WTOUT = OFF_WTIN + (size_t)2 * NP * DM * 2;
constexpr size_t OFF_WTUKV = OFF_WTOUT + (size_t)2 * DM * DM * 2;
constexpr size_t OFF_WTUQ = OFF_WTUKV + (size_t)2 * 512 * 128 * 2;
constexpr size_t OFF_WTGLU = OFF_WTUQ + (size_t)2 * 384 * 192 * 2;
constexpr size_t OFF_WTPOOL = OFF_WTGLU + (size_t)2 * 256 * 256 * 2;
constexpr size_t OFF_WS16 = OFF_WTPOOL + (size_t)2 * 4 * 64 * 64 * 2;
constexpr size_t OFF_MODP = OFF_WS16 + (size_t)2 * 4 * 128 * 128 * 2;
constexpr size_t OFF_LB = OFF_MODP + (size_t)2 * KSPLIT * 5 * 3072 * 4;
constexpr size_t OFF_BBR = OFF_LB + (size_t)4096 * 2 * 4;
constexpr size_t OFF_BBI = OFF_BBR + (size_t)4096 * 16 * 2;
constexpr size_t OFF_CM = OFF_BBI + (size_t)4096 * 16 * 2;
constexpr size_t OFF_ROPE = OFF_CM + (size_t)64 * 16 * 128 * 2;
constexpr size_t OFF_E = OFF_ROPE + (size_t)8192 * 16 * 2 * 4;
constexpr size_t OFF_CTX1 = OFF_E + (size_t)2 * 4 * 66 * 16 * 64 * 2 * 4;
constexpr size_t OFF_H = OFF_CTX1 + (size_t)NCTX * DM * 4;
constexpr size_t OFF_PROJ = OFF_H + (size_t)NTOK * DM * 2;
constexpr size_t OFF_Y = OFF_PROJ + (size_t)NTOK * NP * 2;
constexpr size_t OFF_Q = OFF_Y + (size_t)NTOK * DM * 2;
constexpr size_t OFF_K = OFF_Q + (size_t)16 * SKV * 96 * 2;
constexpr size_t OFF_V = OFF_K + (size_t)16 * SKV * 96 * 2;
constexpr size_t OFF_BAR = OFF_V + (size_t)16 * SKV * 64 * 2;
constexpr size_t OFF_CNT = OFF_BAR + 16384;
constexpr size_t BAR_BYTES = 16384 + 256;
constexpr size_t WS_END = OFF_CNT + 256;

constexpr int LDS_BYTES = 147456;

struct Params {
    const float *x, *c, *ctx, *c_ctx, *w_mod, *b_mod, *w_in, *g_q, *w_uq, *g_kv, *w_ukv, *w_pool, *pool_scale, *lam_re, *lam_im, *log_dt,
        *b_re, *b_im, *c_re, *c_im, *s5_d, *w_glu, *b_glu, *sgu_g, *sgu_b, *w_s, *b_s, *w_out, *ln_g, *ln_b;
    float* out; unsigned char* ws;
};

DI int otid() { int t = threadIdx.x; asm volatile("" : "+v"(t)); return t; }
typedef float f32x2_ __attribute__((ext_vector_type(2)));
typedef __bf16 bf16x2_ __attribute__((ext_vector_type(2)));
DI unsigned cvtpk(float lo, float hi) { const f32x2_ v = {lo, hi}; const bf16x2_ b = __builtin_convertvector(v, bf16x2_); return __builtin_bit_cast(unsigned, b); }
DI float bflo(unsigned w) { return __uint_as_float(w << 16); }
DI float bfhi(unsigned w) { return __uint_as_float(w & 0xffff0000u); }
DI float bf2f(u16 v) { return __uint_as_float(((unsigned)v) << 16); }
DI u16 f2bf(float x) { return (u16)(cvtpk(x, x) & 0xffffu); }
DI int crow(int r, int hi) { return (r & 3) + 8 * (r >> 2) + 4 * hi; }
template <int CTRL> DI float dpp_f(float v) { return __builtin_bit_cast(float, __builtin_amdgcn_update_dpp(0, __builtin_bit_cast(int, v), CTRL, 0xf, 0xf, true)); }
DI float wave_sum(float v) {
    v += dpp_f<0xB1>(v);
    v += dpp_f<0x4E>(v);
    v += dpp_f<0x141>(v);
    v += dpp_f<0x140>(v);
    const int iv = __builtin_bit_cast(int, v);
    const float a = __builtin_bit_cast(float, __builtin_amdgcn_readlane(iv, 0)), b = __builtin_bit_cast(float, __builtin_amdgcn_readlane(iv, 16));
    const float c = __builtin_bit_cast(float, __builtin_amdgcn_readlane(iv, 32)), d = __builtin_bit_cast(float, __builtin_amdgcn_readlane(iv, 48));
    return (a + b) + (c + d);
}
DI float fexp2(float x) { return __builtin_amdgcn_exp2f(x); }
DI float sigmoidf_(float x) { return __builtin_amdgcn_rcpf(1.f + fexp2(-1.4426950408889634f * x)); }
DI float siluf_(float x) { return x * sigmoidf_(x); }
DI float gelu_tanh(float y) { const float u = 0.7978845608028654f * (y + 0.044715f * y * y * y); return y * sigmoidf_(2.f * u); }
#define MFMA32(a, b, c) __builtin_amdgcn_mfma_f32_32x32x16_bf16((a), (b), (c), 0, 0, 0)
#define MFMA16(a, b, c) __builtin_amdgcn_mfma_f32_16x16x32_bf16((a), (b), (c), 0, 0, 0)

DI void sincos_acc(float x, float& s, float& c) {
    const float k = rintf(x * 0.6366197723675814f);
    float r = fmaf(k, -1.5707963705062866f, x);
    r = fmaf(k, 4.371138828673793e-8f, r);
    const int q = ((int)k) & 3;
    const float r2 = r * r;
    const float sp = fmaf(r * r2, fmaf(r2, fmaf(r2, -1.9515295891e-4f, 8.3321608736e-3f), -1.6666654611e-1f), r);
    const float cp = fmaf(r2 * r2, fmaf(r2, fmaf(r2, 2.443315711809948e-5f, -1.388731625493765e-3f), 4.166664568298827e-2f), fmaf(r2, -0.5f, 1.f));
    const float s0 = (q & 1) ? cp : sp, c0 = (q & 1) ? sp : cp;
    s = (q & 2) ? -s0 : s0;
    c = ((q == 1) || (q == 2)) ? -c0 : c0;
}

DI void transpose_tile(const float* __restrict__ src, int C, int r0, int c0, u16* __restrict__ dst, int ldd, float* tile) {
    const int tid = otid();
#pragma unroll
    for (int i = 0; i < 2; ++i) {
        const int r = (tid >> 4) + 32 * i, c = (tid & 15) * 4;
        f32x4 v = {0.f, 0.f, 0.f, 0.f};
        if (c0 + c < C) v = *(const f32x4*)(src + (size_t)(r0 + r) * C + c0 + c);
        tile[r * 65 + c] = v[0]; tile[r * 65 + c + 1] = v[1]; tile[r * 65 + c + 2] = v[2]; tile[r * 65 + c + 3] = v[3];
    }
    __syncthreads();
    const int c = tid >> 3, r8 = (tid & 7) * 8;
    if (c0 + c < C) {
        u32x4 w;
        w.x = cvtpk(tile[(r8 + 0) * 65 + c], tile[(r8 + 1) * 65 + c]); w.y = cvtpk(tile[(r8 + 2) * 65 + c], tile[(r8 + 3) * 65 + c]);
        w.z = cvtpk(tile[(r8 + 4) * 65 + c], tile[(r8 + 5) * 65 + c]); w.w = cvtpk(tile[(r8 + 6) * 65 + c], tile[(r8 + 7) * 65 + c]);
        *(u32x4*)(dst + (size_t)(c0 + c) * ldd + r0 + r8) = w;
    }
    __syncthreads();
}

DI void phase_w(const Params& p, unsigned char* smem) {
    float* tile = (float*)smem;
    const int tid = otid();
    u16* wtin = (u16*)(p.ws + OFF_WTIN); u16* wtout = (u16*)(p.ws + OFF_WTOUT); u16* wtukv = (u16*)(p.ws + OFF_WTUKV); u16* wtuq = (u16*)(p.ws + OFF_WTUQ);
    u16* wtglu = (u16*)(p.ws + OFF_WTGLU); u16* wtpool = (u16*)(p.ws + OFF_WTPOOL); u16* ws16 = (u16*)(p.ws + OFF_WS16);
    constexpr int T_IN = 16 * 38, T_OUT = 256, T_UKV = 16, T_UQ = 18, T_GLU = 16, T_POOL = 4, T_L = T_IN + T_OUT + T_UKV + T_UQ + T_GLU + T_POOL;
    constexpr int U_TR = 2 * T_L, U_PAD = 80, U_WS = 32, U_MOD = 2 * 6 * KSPLIT, U_S5 = 8, U_ROPE = 256;
    constexpr int U_TOT = U_TR + U_PAD + U_WS + U_MOD + U_S5 + U_ROPE;
    for (int u = blockIdx.x; u < U_TOT; u += gridDim.x) {
        int v = u;
        if (v < U_TR) {
            const int l = v / T_L; int t = v % T_L;
            if (t < T_IN) { transpose_tile(p.w_in + (size_t)l * DM * NIN, NIN, (t / 38) * 64, (t % 38) * 64, wtin + (size_t)l * NP * DM, DM, tile); continue; }
            t -= T_IN;
            if (t < T_OUT) { transpose_tile(p.w_out + (size_t)l * DM * DM, DM, (t / 16) * 64, (t % 16) * 64, wtout + (size_t)l * DM * DM, DM, tile); continue; }
            t -= T_OUT;
            if (t < T_UKV) { transpose_tile(p.w_ukv + (size_t)l * 128 * 512, 512, (t / 8) * 64, (t % 8) * 64, wtukv + (size_t)l * 512 * 128, 128, tile); continue; }
            t -= T_UKV;
            if (t < T_UQ) { transpose_tile(p.w_uq + (size_t)l * 192 * 384, 384, (t / 6) * 64, (t % 6) * 64, wtuq + (size_t)l * 384 * 192, 192, tile); continue; }
            t -= T_UQ;
            if (t < T_GLU) { transpose_tile(p.w_glu + (size_t)l * 256 * 256, 256, (t / 4) * 64, (t % 4) * 64, wtglu + (size_t)l * 256 * 256, 256, tile); continue; }
            t -= T_GLU;
            transpose_tile(p.w_pool + (size_t)(l * 4 + t) * 64 * 64, 64, 0, 0, wtpool + (size_t)(l * 4 + t) * 64 * 64, 64, tile);
            continue;
        }
        v -= U_TR;
        if (v < U_PAD) {
            const int e = (v * 512 + tid) * 8; const int l = e / (160 * 1024), o = e % (160 * 1024);
            *(u32x4*)(wtin + (size_t)l * NP * DM + (size_t)NIN * DM + o) = (u32x4){0u, 0u, 0u, 0u};
            continue;
        }
        v -= U_PAD;
        if (v < U_WS) {
            const int e = (v * 512 + tid) * 8;
            const f32x4 a = *(const f32x4*)(p.w_s + e), b = *(const f32x4*)(p.w_s + e + 4);
            u32x4 w; w.x = cvtpk(a[0], a[1]); w.y = cvtpk(a[2], a[3]); w.z = cvtpk(b[0], b[1]); w.w = cvtpk(b[2], b[3]);
            *(u32x4*)(ws16 + e) = w;
            continue;
        }
        v -= U_WS;
        if (v < U_MOD) {
            const int l = v / (6 * KSPLIT), chunk = (v / KSPLIT) % 6, ks = v % KSPLIT;
            constexpr int KL = DM / KSPLIT;
            float* sv = (float*)smem;
            for (int i = tid; i < 5 * KL; i += 512) { const int j = i / KL, kk = i % KL; const float a = (j < 4) ? p.c[j * DM + ks * KL + kk] : p.c_ctx[ks * KL + kk]; sv[i] = siluf_(a); }
            __syncthreads();
            const int n = chunk * 512 + tid;
            const float* wp = p.w_mod + (size_t)l * DM * 3072 + (size_t)(ks * KL) * 3072 + n;
            float a0 = 0.f, a1 = 0.f, a2 = 0.f, a3 = 0.f, a4 = 0.f;
#pragma unroll 8
            for (int kk = 0; kk < KL; ++kk) { const float w = wp[(size_t)kk * 3072]; a0 = fmaf(sv[kk], w, a0); a1 = fmaf(sv[KL + kk], w, a1); a2 = fmaf(sv[2 * KL + kk], w, a2); a3 = fmaf(sv[3 * KL + kk], w, a3); a4 = fmaf(sv[4 * KL + kk], w, a4); }
            float* mp = (float*)(p.ws + OFF_MODP) + (size_t)((l * KSPLIT + ks) * 5) * 3072 + n;
            mp[0] = a0; mp[3072] = a1; mp[2 * 3072] = a2; mp[3 * 3072] = a3; mp[4 * 3072] = a4;
            __syncthreads();
            continue;
        }
        v -= U_MOD;
        if (v < U_S5) {
            const int idx = v * 512 + tid;
            const float lr = p.lam_re[idx], li = p.lam_im[idx], dt = expf(p.log_dt[idx >> 6]);
            const float mag = expf(lr * dt); float sn, cs; sincos_acc(li * dt, sn, cs);
            const float lbr = mag * cs, lbi = mag * sn, nr = lbr - 1.f, ni = lbi, den = lr * lr + li * li;
            const float kr = (nr * lr + ni * li) / den, ki = (ni * lr - nr * li) / den;
            float* lb = (float*)(p.ws + OFF_LB); lb[idx * 2] = lbr; lb[idx * 2 + 1] = lbi;
            u16* bbr = (u16*)(p.ws + OFF_BBR) + (size_t)idx * 16; u16* bbi = (u16*)(p.ws + OFF_BBI) + (size_t)idx * 16;
            u16* cm = (u16*)(p.ws + OFF_CM);
            const int pp = idx & 63;
            for (int h = 0; h < 16; ++h) {
                const float br = p.b_re[(size_t)idx * 16 + h], bi = p.b_im[(size_t)idx * 16 + h];
                bbr[h] = f2bf(kr * br - ki * bi); bbi[h] = f2bf(kr * bi + ki * br);
                const size_t ci = ((size_t)(idx >> 6) * 16 + h) * 64 + pp;
                *(unsigned*)(cm + ((size_t)(idx >> 6) * 16 + h) * 128 + 2 * pp) = cvtpk(p.c_re[ci], -p.c_im[ci]);
            }
            continue;
        }
        v -= U_S5;
        {
            const int it = v * 512 + tid; const int t = it >> 4, a = (it >> 3) & 1, f = it & 7;
            const float pos = (float)(a ? (t & 63) : (t >> 6));
            const float inv = exp2f(-(float)f * 0.125f * 13.287712379549449f);
            float sn, cs; sincos_acc(pos * inv, sn, cs);
            float* rp = (float*)(p.ws + OFF_ROPE) + (size_t)it * 2; rp[0] = cs; rp[1] = sn;
        }
    }
}

DI void load_mod(const Params& p, int l, int j, int which, float* dst) {
    const float* mp = (const float*)(p.ws + OFF_MODP);
    for (int c = otid(); c < DM; c += 512) {
        float v = p.b_mod[l * 3072 + which * DM + c];
#pragma unroll
        for (int ks = 0; ks < KSPLIT; ++ks) v += mp[(size_t)((l * KSPLIT + ks) * 5 + j) * 3072 + which * DM + c];
        dst[c] = v;
    }
}

DI void phase_a(const Params& p, unsigned char* smem) {
    float* shift = (float*)smem; float* scale = shift + DM;
    u16* hb = (u16*)(p.ws + OFF_H);
    const int tid = otid(), wid = __builtin_amdgcn_readfirstlane(tid >> 6), lane = tid & 63;
    for (int u = blockIdx.x; u < 512; u += gridDim.x) {
        const bool cx = u >= 256; const int r0 = cx ? NLAT + (u - 256) * 4 : u * 128; const int j = cx ? 4 : (r0 >> 13);
        const int rpw = cx ? 1 : 16;
        __syncthreads();
        load_mod(p, 0, j, 0, shift); load_mod(p, 0, j, 1, scale);
        __syncthreads();
        if (cx && wid >= 4) continue;
        const int rowb = r0 + wid * rpw;
        const float* xb_ = (rowb < NLAT) ? p.x + (size_t)rowb * DM : p.ctx + (size_t)(rowb - NLAT) * DM;
        f32x4 nx[4];
#pragma unroll
        for (int i = 0; i < 4; ++i) nx[i] = __builtin_nontemporal_load((const f32x4*)(xb_ + i * 256 + lane * 4));
        f32x4 sc4[4], sh4[4];
#pragma unroll
        for (int i = 0; i < 4; ++i) { sc4[i] = *(const f32x4*)(scale + i * 256 + lane * 4); sh4[i] = *(const f32x4*)(shift + i * 256 + lane * 4); }
        for (int rr = 0; rr < rpw; ++rr) {
            const int row = rowb + rr;
            f32x4 v[4]; float s = 0.f;
#pragma unroll
            for (int i = 0; i < 4; ++i) { v[i] = nx[i]; s += v[i][0] + v[i][1] + v[i][2] + v[i][3]; }
            if (rr + 1 < rpw) {
#pragma unroll
                for (int i = 0; i < 4; ++i) nx[i] = __builtin_nontemporal_load((const f32x4*)(xb_ + (size_t)(rr + 1) * DM + i * 256 + lane * 4));
            }
            const float mean = wave_sum(s) * (1.f / DM);
            float q = 0.f;
#pragma unroll
            for (int i = 0; i < 4; ++i)
#pragma unroll
                for (int k = 0; k < 4; ++k) { const float d = v[i][k] - mean; q += d * d; }
            const float rstd = rsqrtf(wave_sum(q) * (1.f / DM) + LN_EPS);
#pragma unroll
            for (int i = 0; i < 4; ++i) {
                const int c = i * 256 + lane * 4; float o[4];
#pragma unroll
                for (int k = 0; k < 4; ++k) o[k] = (v[i][k] - mean) * rstd * (1.f + sc4[i][k]) + sh4[i][k];
                u32x2 w; w.x = cvtpk(o[0], o[1]); w.y = cvtpk(o[2], o[3]);
                *(u32x2*)(hb + (size_t)row * DM + c) = w;
            }
        }
    }
}

#ifndef S5_OUT_SCALE
#define S5_OUT_SCALE 1.f
#endif
#ifndef SGU_OUT_SCALE
#define SGU_OUT_SCALE 1.f
#endif
#ifndef POOL_OUT_SCALE
#define POOL_OUT_SCALE 1.f
#endif
#ifndef Y_SCALE
#define Y_SCALE 1.f
#endif
DI void phase_f(const Params& p, int l, unsigned char* smem) {
    float* gate = (float*)smem; float* shift = gate + DM; float* scale = shift + DM;
    const u16* yb = (const u16*)(p.ws + OFF_Y);
    u16* hb = (u16*)(p.ws + OFF_H);
    float* ctx1 = (float*)(p.ws + OFF_CTX1);
    const int tid = otid(), wid = __builtin_amdgcn_readfirstlane(tid >> 6), lane = tid & 63;
    const float* lg = p.ln_g + l * DM; const float* lbv = p.ln_b + l * DM;
    for (int u = blockIdx.x; u < (l ? 256 : 512); u += gridDim.x) {
        const bool cx = u >= 256; const int r0 = cx ? NLAT + (u - 256) * 4 : u * 128; const int j = cx ? 4 : (r0 >> 13);
        const int rpw = cx ? 1 : 16;
        __syncthreads();
        load_mod(p, l, j, 2, gate);
        if (l == 0) { load_mod(p, 1, j, 0, shift); load_mod(p, 1, j, 1, scale); }
        __syncthreads();
        if (cx && wid >= 4) continue;
        const int rowb = r0 + wid * rpw;
        const float* xb_; float* ob_;
        if (l == 0) { xb_ = (rowb < NLAT) ? p.x + (size_t)rowb * DM : p.ctx + (size_t)(rowb - NLAT) * DM; ob_ = (rowb < NLAT) ? p.out + (size_t)rowb * DM : ctx1 + (size_t)(rowb - NLAT) * DM; }
        else { xb_ = p.out + (size_t)rowb * DM; ob_ = p.out + (size_t)rowb * DM; }
        f32x4 nx[4]; u32x2 ny[4];
#pragma unroll
        for (int i = 0; i < 4; ++i) { nx[i] = __builtin_nontemporal_load((const f32x4*)(xb_ + i * 256 + lane * 4)); ny[i] = *(const u32x2*)(yb + (size_t)rowb * DM + i * 256 + lane * 4); }
        f32x4 gt4[4], g4r[4], b4r[4], sc4[4], sh4[4];
#pragma unroll
        for (int i = 0; i < 4; ++i) {
            const int c = i * 256 + lane * 4;
            gt4[i] = *(const f32x4*)(gate + c); g4r[i] = *(const f32x4*)(lg + c); b4r[i] = *(const f32x4*)(lbv + c);
            if (l == 0) { sc4[i] = *(const f32x4*)(scale + c); sh4[i] = *(const f32x4*)(shift + c); }
        }
        for (int rr = 0; rr < rpw; ++rr) {
            const int row = rowb + rr;
            float* op = ob_ + (size_t)rr * DM;
            f32x4 v[4]; float s = 0.f;
            f32x4 cx[4]; u32x2 cy[4];
#pragma unroll
            for (int i = 0; i < 4; ++i) { cx[i] = nx[i]; cy[i] = ny[i]; }
            if (rr + 1 < rpw) {
#pragma unroll
                for (int i = 0; i < 4; ++i) { nx[i] = __builtin_nontemporal_load((const f32x4*)(xb_ + (size_t)(rr + 1) * DM + i * 256 + lane * 4)); ny[i] = *(const u32x2*)(yb + (size_t)(row + 1) * DM + i * 256 + lane * 4); }
            }
#pragma unroll
            for (int i = 0; i < 4; ++i) {
                const int c = i * 256 + lane * 4;
                const f32x4 xv = cx[i]; const u32x2 yw = cy[i];
                v[i][0] = ALPHA * xv[0] + Y_SCALE * gt4[i][0] * bflo(yw.x); v[i][1] = ALPHA * xv[1] + Y_SCALE * gt4[i][1] * bfhi(yw.x);
                v[i][2] = ALPHA * xv[2] + Y_SCALE * gt4[i][2] * bflo(yw.y); v[i][3] = ALPHA * xv[3] + Y_SCALE * gt4[i][3] * bfhi(yw.y);
                s += v[i][0] + v[i][1] + v[i][2] + v[i][3];
            }
            const float mean = wave_sum(s) * (1.f / DM);
            float q = 0.f;
#pragma unroll
            for (int i = 0; i < 4; ++i)
#pragma unroll
                for (int k = 0; k < 4; ++k) { const float d = v[i][k] - mean; q += d * d; }
            const float rstd = rsqrtf(wave_sum(q) * (1.f / DM) + LN_EPS);
            float s2 = 0.f;
#pragma unroll
            for (int i = 0; i < 4; ++i) {
                const int c = i * 256 + lane * 4;
#pragma unroll
                for (int k = 0; k < 4; ++k) { v[i][k] = (v[i][k] - mean) * rstd * g4r[i][k] + b4r[i][k]; s2 += v[i][k]; }
                __builtin_nontemporal_store(v[i], (f32x4*)(op + c));
            }
            if (l == 0) {
                const float m2 = wave_sum(s2) * (1.f / DM);
                float q2 = 0.f;
#pragma unroll
                for (int i = 0; i < 4; ++i)
#pragma unroll
                    for (int k = 0; k < 4; ++k) { const float d = v[i][k] - m2; q2 += d * d; }
                const float rs2 = rsqrtf(wave_sum(q2) * (1.f / DM) + LN_EPS);
#pragma unroll
                for (int i = 0; i < 4; ++i) {
                    const int c = i * 256 + lane * 4; float o[4];
#pragma unroll
                    for (int k = 0; k < 4; ++k) o[k] = (v[i][k] - m2) * rs2 * (1.f + sc4[i][k]) + sh4[i][k];
                    u32x2 w; w.x = cvtpk(o[0], o[1]); w.y = cvtpk(o[2], o[3]);
                    *(u32x2*)(hb + (size_t)row * DM + c) = w;
                }
            }
        }
    }
}

DI void phase_gemm(const u16* A, const u16* Bt, u16* O, int M, int N, int ldc, unsigned char* smem) {
    pg8::Gemm g; g.A = A; g.Bt = Bt; g.M = M; g.N = N; g.K = DM;
    pg8::StaticOrder S; S.init(M, N, (int)gridDim.x, (int)blockIdx.x);
    pg8::EpiStoreBf16 E; E.O = O; E.ldc = ldc;
    pg8::gemm_phase<pg8::EpiStoreBf16, pg8::StaticOrder, false>((PG8_LAS unsigned char*)smem, g, S, E, nullptr);
}

struct OneUnitOrder {
    int pm, pn;
    __device__ __forceinline__ bool next(int i, pg8::Unit& u) const { if (i != 0) return false; u.pm = pm; u.pn = pn; return true; }
    __device__ __forceinline__ void a_ready(const pg8::Unit&) const {}
    __device__ __forceinline__ void done(const pg8::Unit&) const {}
};
DI void unit_gemm_one(const u16* A, const u16* Bt, u16* O, int N, int pm, int pn, unsigned char* smem) {
    pg8::Gemm g; g.A = A; g.Bt = Bt; g.M = NTOK; g.N = N; g.K = DM;
    OneUnitOrder S; S.pm = pm; S.pn = pn;
    pg8::EpiStoreBf16 E; E.O = O; E.ldc = N;
    __syncthreads();
    pg8::gemm_phase<pg8::EpiStoreBf16, OneUnitOrder, false>((PG8_LAS unsigned char*)smem, g, S, E, nullptr);
}
DI void publish_unit(unsigned* cnt) {
    asm volatile("s_waitcnt vmcnt(0)" ::: "memory");
    __syncthreads();
    if (threadIdx.x == 0) { __threadfence(); __hip_atomic_fetch_add(cnt, 1u, __ATOMIC_RELEASE, __HIP_MEMORY_SCOPE_AGENT); }
}
DI void wait_units(const unsigned* cnt, unsigned need) {
    if (threadIdx.x == 0) { while (__hip_atomic_load(cnt, __ATOMIC_RELAXED, __HIP_MEMORY_SCOPE_AGENT) < need) __builtin_amdgcn_s_sleep(8); }
    __syncthreads();
    asm volatile("buffer_inv sc1\n\ts_waitcnt vmcnt(0)" ::: "memory");
}
DI void unit_gemm_ctx(const Params& p, int l, int i, unsigned char* smem, unsigned* done_cnt) {
    const int npn = l ? 2 : 10;
    pg8::Gemm g; g.A = (const u16*)(p.ws + OFF_H); g.Bt = (const u16*)(p.ws + OFF_WTIN) + (size_t)l * NP * DM; g.M = NTOK; g.N = NP; g.K = DM;
    OneUnitOrder S; S.pm = 128 + i / npn; S.pn = i % npn;
    pg8::EpiStoreBf16 E; E.O = (u16*)(p.ws + OFF_PROJ); E.ldc = NP;
    __syncthreads();
    pg8::gemm_phase<pg8::EpiStoreBf16, OneUnitOrder, false>((PG8_LAS unsigned char*)smem, g, S, E, nullptr);
    asm volatile("s_waitcnt vmcnt(0)" ::: "memory");
    __syncthreads();
    if (threadIdx.x == 0) { __threadfence(); __hip_atomic_fetch_add(done_cnt, 1u, __ATOMIC_RELEASE, __HIP_MEMORY_SCOPE_AGENT); }
}

DI void row_info(int r, int& b, int& t, int& isctx) { if (r < NLAT) { b = r >> 13; t = r & 8191; isctx = 0; } else { const int rc = r - NLAT; b = rc >> 8; t = rc & 255; isctx = 1; } }

DI void unit_mla(const Params& p, int l, int u, unsigned char* smem) {
    const int tid = otid(), wid = __builtin_amdgcn_readfirstlane(tid >> 6), lane = tid & 63, r32 = lane & 31, hi = lane >> 5;
    const u16* proj = (const u16*)(p.ws + OFF_PROJ);
    u16* Qg = (u16*)(p.ws + OFF_Q); u16* Kg = (u16*)(p.ws + OFF_K); u16* Vg = (u16*)(p.ws + OFF_V);
    const float* rope = (const float*)(p.ws + OFF_ROPE);
    u16* Akv = (u16*)smem;
    u16* Aq = (u16*)(smem + 64 * 272);
    const int r0 = u * 64; int b, t0, isctx; row_info(r0, b, t0, isctx);
    const int s0 = isctx ? t0 : 256 + t0;
    __syncthreads();
    {
        const int m = tid >> 3, q = tid & 7; const u16* pr = proj + (size_t)(r0 + m) * NP;
        u32x4 kv[2], cq[3], krv = {0u, 0u, 0u, 0u};
#pragma unroll
        for (int i = 0; i < 2; ++i) kv[i] = *(const u32x4*)(pr + C_CKV + q * 16 + i * 8);
#pragma unroll
        for (int i = 0; i < 3; ++i) cq[i] = *(const u32x4*)(pr + C_CQ + q * 24 + i * 8);
        if (q < 4) krv = *(const u32x4*)(pr + C_KR + q * 8);
        f32x4 gk[4], gq[6];
#pragma unroll
        for (int i = 0; i < 4; ++i) gk[i] = *(const f32x4*)(p.g_kv + l * 128 + q * 16 + i * 4);
#pragma unroll
        for (int i = 0; i < 6; ++i) gq[i] = *(const f32x4*)(p.g_q + l * 192 + q * 24 + i * 4);
        float cs[8], sn[8];
        if (q < 4 && !isctx) {
            const float* rp = rope + ((size_t)(t0 + m) * 16 + (q >> 1) * 8) * 2;
#pragma unroll
            for (int i = 0; i < 4; ++i) { const f32x4 v = *(const f32x4*)(rp + i * 4); cs[2 * i] = v[0]; sn[2 * i] = v[1]; cs[2 * i + 1] = v[2]; sn[2 * i + 1] = v[3]; }
        } else {
#pragma unroll
            for (int i = 0; i < 8; ++i) { cs[i] = 1.f; sn[i] = 0.f; }
        }
        { float x[16]; float ss = 0.f;
#pragma unroll
          for (int i = 0; i < 2; ++i) { x[8 * i] = bflo(kv[i].x); x[8 * i + 1] = bfhi(kv[i].x); x[8 * i + 2] = bflo(kv[i].y); x[8 * i + 3] = bfhi(kv[i].y);
              x[8 * i + 4] = bflo(kv[i].z); x[8 * i + 5] = bfhi(kv[i].z); x[8 * i + 6] = bflo(kv[i].w); x[8 * i + 7] = bfhi(kv[i].w); }
#pragma unroll
          for (int i = 0; i < 16; ++i) ss += x[i] * x[i];
          ss += dpp_f<0xB1>(ss); ss += dpp_f<0x4E>(ss); ss += dpp_f<0x141>(ss);
          const float rs = rsqrtf(ss * (1.f / 128.f) + LN_EPS);
#pragma unroll
          for (int i = 0; i < 2; ++i) { u32x4 w;
              w.x = cvtpk(x[8 * i] * rs * gk[2 * i][0], x[8 * i + 1] * rs * gk[2 * i][1]); w.y = cvtpk(x[8 * i + 2] * rs * gk[2 * i][2], x[8 * i + 3] * rs * gk[2 * i][3]);
              w.z = cvtpk(x[8 * i + 4] * rs * gk[2 * i + 1][0], x[8 * i + 5] * rs * gk[2 * i + 1][1]); w.w = cvtpk(x[8 * i + 6] * rs * gk[2 * i + 1][2], x[8 * i + 7] * rs * gk[2 * i + 1][3]);
              *(u32x4*)(Akv + m * 136 + q * 16 + i * 8) = w; } }
        { float x[24]; float ss = 0.f;
#pragma unroll
          for (int i = 0; i < 3; ++i) { x[8 * i] = bflo(cq[i].x); x[8 * i + 1] = bfhi(cq[i].x); x[8 * i + 2] = bflo(cq[i].y); x[8 * i + 3] = bfhi(cq[i].y);
              x[8 * i + 4] = bflo(cq[i].z); x[8 * i + 5] = bfhi(cq[i].z); x[8 * i + 6] = bflo(cq[i].w); x[8 * i + 7] = bfhi(cq[i].w); }
#pragma unroll
          for (int i = 0; i < 24; ++i) ss += x[i] * x[i];
          ss += dpp_f<0xB1>(ss); ss += dpp_f<0x4E>(ss); ss += dpp_f<0x141>(ss);
          const float rs = rsqrtf(ss * (1.f / 192.f) + LN_EPS);
#pragma unroll
          for (int i = 0; i < 3; ++i) { u32x4 w;
              w.x = cvtpk(x[8 * i] * rs * gq[2 * i][0], x[8 * i + 1] * rs * gq[2 * i][1]); w.y = cvtpk(x[8 * i + 2] * rs * gq[2 * i][2], x[8 * i + 3] * rs * gq[2 * i][3]);
              w.z = cvtpk(x[8 * i + 4] * rs * gq[2 * i + 1][0], x[8 * i + 5] * rs * gq[2 * i + 1][1]); w.w = cvtpk(x[8 * i + 6] * rs * gq[2 * i + 1][2], x[8 * i + 7] * rs * gq[2 * i + 1][3]);
              *(u32x4*)(Aq + m * 200 + q * 24 + i * 8) = w; } }
        { u32x4 pw;
          pw.x = (unsigned)__builtin_amdgcn_update_dpp(0, (int)krv.x, 0xB1, 0xf, 0xf, true); pw.y = (unsigned)__builtin_amdgcn_update_dpp(0, (int)krv.y, 0xB1, 0xf, 0xf, true);
          pw.z = (unsigned)__builtin_amdgcn_update_dpp(0, (int)krv.z, 0xB1, 0xf, 0xf, true); pw.w = (unsigned)__builtin_amdgcn_update_dpp(0, (int)krv.w, 0xB1, 0xf, 0xf, true);
          if (q < 4) {
              const float sg = (q & 1) ? 1.f : -1.f;
              float me[8], ot[8];
              me[0] = bflo(krv.x); me[1] = bfhi(krv.x); me[2] = bflo(krv.y); me[3] = bfhi(krv.y); me[4] = bflo(krv.z); me[5] = bfhi(krv.z); me[6] = bflo(krv.w); me[7] = bfhi(krv.w);
              ot[0] = bflo(pw.x); ot[1] = bfhi(pw.x); ot[2] = bflo(pw.y); ot[3] = bfhi(pw.y); ot[4] = bflo(pw.z); ot[5] = bfhi(pw.z); ot[6] = bflo(pw.w); ot[7] = bfhi(pw.w);
              float o[8];
#pragma unroll
              for (int i = 0; i < 8; ++i) o[i] = me[i] * cs[i] + sg * ot[i] * sn[i];
              u32x4 w; w.x = cvtpk(o[0], o[1]); w.y = cvtpk(o[2], o[3]); w.z = cvtpk(o[4], o[5]); w.w = cvtpk(o[6], o[7]);
#pragma unroll
              for (int h = 0; h < 4; ++h) *(u32x4*)(Kg + ((size_t)(b * 4 + h) * SKV + s0 + m) * 96 + 64 + q * 8) = w;
          } }
    }
    __syncthreads();
    {
        const int h = wid >> 1, part = wid & 1, n0 = h * 128 + part * 64;
        const u16* W = (const u16*)(p.ws + OFF_WTUKV) + (size_t)l * 512 * 128;
        f32x16 acc[2][2];
#pragma unroll
        for (int i = 0; i < 2; ++i)
#pragma unroll
            for (int j = 0; j < 2; ++j)
#pragma unroll
                for (int r = 0; r < 16; ++r) acc[i][j][r] = 0.f;
#pragma unroll
        for (int ks = 0; ks < 8; ++ks) {
            bf16x8 af[2], bf[2];
#pragma unroll
            for (int i = 0; i < 2; ++i) af[i] = *(const bf16x8*)(Akv + (i * 32 + r32) * 136 + ks * 16 + hi * 8);
#pragma unroll
            for (int j = 0; j < 2; ++j) bf[j] = *(const bf16x8*)(W + (size_t)(n0 + j * 32 + r32) * 128 + ks * 16 + hi * 8);
#pragma unroll
            for (int i = 0; i < 2; ++i)
#pragma unroll
                for (int j = 0; j < 2; ++j) acc[i][j] = MFMA32(bf[j], af[i], acc[i][j]);
        }
        u16* dst = part ? Vg : Kg; const int ld = part ? 64 : 96;
#pragma unroll
        for (int i = 0; i < 2; ++i)
#pragma unroll
            for (int j = 0; j < 2; ++j)
#pragma unroll
                for (int r4 = 0; r4 < 4; ++r4) {
                    u32x2 w; w.x = cvtpk(acc[i][j][4 * r4], acc[i][j][4 * r4 + 1]); w.y = cvtpk(acc[i][j][4 * r4 + 2], acc[i][j][4 * r4 + 3]);
                    *(u32x2*)(dst + ((size_t)(b * 4 + h) * SKV + s0 + i * 32 + r32) * ld + j * 32 + 8 * r4 + 4 * hi) = w;
                }
    }
    for (int blk = wid; blk < 12; blk += 8) {
        const int h = blk / 3, part = blk % 3, n0 = blk * 32;
        const u16* W = (const u16*)(p.ws + OFF_WTUQ) + (size_t)l * 384 * 192;
        f32x16 acc[2];
#pragma unroll
        for (int i = 0; i < 2; ++i)
#pragma unroll
            for (int r = 0; r < 16; ++r) acc[i][r] = 0.f;
#pragma unroll
        for (int ks = 0; ks < 12; ++ks) {
            const bf16x8 bfr = *(const bf16x8*)(W + (size_t)(n0 + r32) * 192 + ks * 16 + hi * 8);
#pragma unroll
            for (int i = 0; i < 2; ++i) { const bf16x8 af = *(const bf16x8*)(Aq + (i * 32 + r32) * 200 + ks * 16 + hi * 8); acc[i] = MFMA32(bfr, af, acc[i]); }
        }
#pragma unroll
        for (int i = 0; i < 2; ++i) {
            const int m = i * 32 + r32;
            if (part == 2 && !isctx) {
                const float* rp = rope + ((size_t)(t0 + m) * 16 + 4 * hi) * 2;
#pragma unroll
                for (int a = 0; a < 2; ++a) {
                    const f32x4 cs0 = *(const f32x4*)(rp + a * 16), cs1 = *(const f32x4*)(rp + a * 16 + 4);
                    const float cc[4] = {cs0[0], cs0[2], cs1[0], cs1[2]}, ss[4] = {cs0[1], cs0[3], cs1[1], cs1[3]};
#pragma unroll
                    for (int k = 0; k < 4; ++k) { const float x1 = acc[i][8 * a + k], x2 = acc[i][8 * a + 4 + k];
                        acc[i][8 * a + k] = x1 * cc[k] - x2 * ss[k]; acc[i][8 * a + 4 + k] = x2 * cc[k] + x1 * ss[k]; }
                }
            }
#pragma unroll
            for (int r4 = 0; r4 < 4; ++r4) {
                u32x2 w; w.x = cvtpk(acc[i][4 * r4] * QSCALE, acc[i][4 * r4 + 1] * QSCALE); w.y = cvtpk(acc[i][4 * r4 + 2] * QSCALE, acc[i][4 * r4 + 3] * QSCALE);
                *(u32x2*)(Qg + ((size_t)(b * 4 + h) * SKV + s0 + m) * 96 + part * 32 + 8 * r4 + 4 * hi) = w;
            }
        }
    }
}

DI void unit_sgu(const Params& p, int l, int u, unsigned char* smem) {
    const int tid = otid(), wid = __builtin_amdgcn_readfirstlane(tid >> 6), lane = tid & 63, r32 = lane & 31, hi = lane >> 5;
    const u16* proj = (const u16*)(p.ws + OFF_PROJ); u16* mix = (u16*)(p.ws + OFF_H);
    u16* vnT = (u16*)smem;
    const int r0 = u * 128;
    __syncthreads();
    {
        const int s = tid >> 2, q = tid & 3; const u16* pr = proj + (size_t)(r0 + s) * NP + C_SV + q * 64;
        float xv[64]; float sum = 0.f;
#pragma unroll
        for (int i = 0; i < 8; ++i) { const u32x4 w = *(const u32x4*)(pr + i * 8);
            xv[i * 8 + 0] = bflo(w.x); xv[i * 8 + 1] = bfhi(w.x); xv[i * 8 + 2] = bflo(w.y); xv[i * 8 + 3] = bfhi(w.y);
            xv[i * 8 + 4] = bflo(w.z); xv[i * 8 + 5] = bfhi(w.z); xv[i * 8 + 6] = bflo(w.w); xv[i * 8 + 7] = bfhi(w.w); }
#pragma unroll
        for (int i = 0; i < 64; ++i) sum += xv[i];
        sum += __shfl_xor(sum, 1); sum += __shfl_xor(sum, 2);
        const float mean = sum * (1.f / 256.f);
        float qq = 0.f;
#pragma unroll
        for (int i = 0; i < 64; ++i) { const float d = xv[i] - mean; qq += d * d; }
        qq += __shfl_xor(qq, 1); qq += __shfl_xor(qq, 2);
        const float rstd = rsqrtf(qq * (1.f / 256.f) + LN_EPS);
        const float* gg = p.sgu_g + l * 256 + q * 64; const float* bb = p.sgu_b + l * 256 + q * 64;
#pragma unroll
        for (int i = 0; i < 64; ++i) vnT[(q * 64 + i) * 136 + s] = f2bf((xv[i] - mean) * rstd * gg[i] + bb[i]);
    }
    __syncthreads();
    {
        const int h = wid >> 1, c0 = h * 64 + (wid & 1) * 32;
        const u16* W = (const u16*)(p.ws + OFF_WS16) + (size_t)(l * 4 + h) * 128 * 128;
        f32x16 acc[4];
#pragma unroll
        for (int i = 0; i < 4; ++i)
#pragma unroll
            for (int r = 0; r < 16; ++r) acc[i][r] = 0.f;
        bf16x8 afr[4][8];
#pragma unroll
        for (int i = 0; i < 4; ++i)
#pragma unroll
            for (int ks = 0; ks < 8; ++ks) afr[i][ks] = *(const bf16x8*)(W + (size_t)(i * 32 + r32) * 128 + ks * 16 + hi * 8);
#pragma unroll
        for (int ks = 0; ks < 8; ++ks) {
            const bf16x8 bfr = *(const bf16x8*)(vnT + (c0 + r32) * 136 + ks * 16 + hi * 8);
#pragma unroll
            for (int i = 0; i < 4; ++i) acc[i] = MFMA32(bfr, afr[i][ks], acc[i]);
        }
#pragma unroll
        for (int i = 0; i < 4; ++i) {
            const int t = i * 32 + r32; const size_t row = (size_t)(r0 + t);
            const float bs = p.b_s[(l * 4 + h) * 128 + t];
#pragma unroll
            for (int r4 = 0; r4 < 4; ++r4) {
                const int c = c0 + 8 * r4 + 4 * hi;
                const u32x2 uw = *(const u32x2*)(proj + row * NP + C_SU + c), gw = *(const u32x2*)(proj + row * NP + C_G + 768 + c);
                const float o0 = bflo(uw.x) * (acc[i][4 * r4] + bs) * siluf_(bflo(gw.x)), o1 = bfhi(uw.x) * (acc[i][4 * r4 + 1] + bs) * siluf_(bfhi(gw.x));
                const float o2 = bflo(uw.y) * (acc[i][4 * r4 + 2] + bs) * siluf_(bflo(gw.y)), o3 = bfhi(uw.y) * (acc[i][4 * r4 + 3] + bs) * siluf_(bfhi(gw.y));
                u32x2 w; w.x = cvtpk(SGU_OUT_SCALE * o0, SGU_OUT_SCALE * o1); w.y = cvtpk(SGU_OUT_SCALE * o2, SGU_OUT_SCALE * o3);
                *(u32x2*)(mix + row * DM + 768 + c) = w;
            }
        }
    }
}

DI void unit_pool(const Params& p, int l, int u, unsigned char* smem) {
    const int tid = otid(), wid = __builtin_amdgcn_readfirstlane(tid >> 6), lane = tid & 63, r32 = lane & 31, hi = lane >> 5;
    const u16* proj = (const u16*)(p.ws + OFF_PROJ); u16* mix = (u16*)(p.ws + OFF_H);
    u16* halo = (u16*)smem;
    u16* At = (u16*)(smem + 80 * 512);
    const int r0 = u * 64; int b, t0, isctx; row_info(r0, b, t0, isctx);
    const int n = isctx ? CTXL : SEQ; const int rbase = r0 - t0;
    __syncthreads();
    for (int i = tid; i < 80 * 32; i += 512) {
        const int hr = i >> 5, ch = i & 31; const int t = t0 - 8 + hr;
        if (t >= 0 && t < n) *(u32x4*)(halo + hr * 256 + ch * 8) = *(const u32x4*)(proj + (size_t)(rbase + t) * NP + C_POOL + ch * 8);
    }
    __syncthreads();
    for (int it = tid; it < 64 * 32; it += 512) {
        const int m = it >> 5, cg = it & 31, gi = cg >> 3, w = 2 << gi; const int t = t0 + m;
        const int lo = max(t - (w >> 1), 0), hiw = min(t + w - (w >> 1), n);
        float s[8];
#pragma unroll
        for (int k = 0; k < 8; ++k) s[k] = 0.f;
        for (int tt = lo; tt < hiw; ++tt) {
            const u32x4 v = *(const u32x4*)(halo + (tt - t0 + 8) * 256 + cg * 8);
            s[0] += bflo(v.x); s[1] += bfhi(v.x); s[2] += bflo(v.y); s[3] += bfhi(v.y); s[4] += bflo(v.z); s[5] += bfhi(v.z); s[6] += bflo(v.w); s[7] += bfhi(v.w);
        }
        const float inv = 1.f / (float)(hiw - lo);
        const u32x4 c = *(const u32x4*)(halo + (m + 8) * 256 + cg * 8);
        u32x4 o;
        o.x = cvtpk(s[0] * inv - bflo(c.x), s[1] * inv - bfhi(c.x)); o.y = cvtpk(s[2] * inv - bflo(c.y), s[3] * inv - bfhi(c.y));
        o.z = cvtpk(s[4] * inv - bflo(c.z), s[5] * inv - bfhi(c.z)); o.w = cvtpk(s[6] * inv - bflo(c.w), s[7] * inv - bfhi(c.w));
        *(u32x4*)(At + m * 264 + cg * 8) = o;
    }
    __syncthreads();
    {
        const int gi = wid >> 1, d0 = (wid & 1) * 32;
        const u16* W = (const u16*)(p.ws + OFF_WTPOOL) + (size_t)(l * 4 + gi) * 64 * 64;
        f32x16 acc[2];
#pragma unroll
        for (int i = 0; i < 2; ++i)
#pragma unroll
            for (int r = 0; r < 16; ++r) acc[i][r] = 0.f;
#pragma unroll
        for (int ks = 0; ks < 4; ++ks) {
            const bf16x8 bfr = *(const bf16x8*)(W + (size_t)(d0 + r32) * 64 + ks * 16 + hi * 8);
#pragma unroll
            for (int i = 0; i < 2; ++i) { const bf16x8 af = *(const bf16x8*)(At + (i * 32 + r32) * 264 + gi * 64 + ks * 16 + hi * 8); acc[i] = MFMA32(bfr, af, acc[i]); }
        }
#pragma unroll
        for (int i = 0; i < 2; ++i) {
            const size_t row = (size_t)(r0 + i * 32 + r32);
#pragma unroll
            for (int r4 = 0; r4 < 4; ++r4) {
                const int c = gi * 64 + d0 + 8 * r4 + 4 * hi;
                const f32x4 ps = *(const f32x4*)(p.pool_scale + l * 256 + c);
                const u32x2 gw = *(const u32x2*)(proj + row * NP + C_G + 256 + c);
                u32x2 w; w.x = cvtpk(POOL_OUT_SCALE * acc[i][4 * r4] * ps[0] * siluf_(bflo(gw.x)), POOL_OUT_SCALE * acc[i][4 * r4 + 1] * ps[1] * siluf_(bfhi(gw.x)));
                w.y = cvtpk(POOL_OUT_SCALE * acc[i][4 * r4 + 2] * ps[2] * siluf_(bflo(gw.y)), POOL_OUT_SCALE * acc[i][4 * r4 + 3] * ps[3] * siluf_(bfhi(gw.y)));
                *(u32x2*)(mix + row * DM + 256 + c) = w;
            }
        }
    }
}

DI void s5_unit_rows(int u, int& r0, int& b, int& cidx) {
    if (u < 256) { r0 = u * 128; b = u >> 6; cidx = 2 + (u & 63); } else { const int uc = u - 256; r0 = NLAT + uc * 128; b = uc >> 1; cidx = uc & 1; }
}
DI int s5_rev_order(int i) { return i == 0 ? 1 : (i == 1 ? 0 : 67 - i); }

DI void s5_bu(const bf16x8 ua, int r32, int hi, const bf16x8 (&bR)[2], const bf16x8 (&bI)[2], unsigned* slab) {
    f32x16 z;
#pragma unroll
    for (int r = 0; r < 16; ++r) z[r] = 0.f;
    const f32x16 re0 = MFMA32(ua, bR[0], z), im0 = MFMA32(ua, bI[0], z), re1 = MFMA32(ua, bR[1], z), im1 = MFMA32(ua, bI[1], z);
#pragma unroll
    for (int r = 0; r < 16; ++r) { const int t = crow(r, hi); slab[t * 68 + r32] = cvtpk(re0[r], im0[r]); slab[t * 68 + 32 + r32] = cvtpk(re1[r], im1[r]); }
    asm volatile("" ::: "memory");
}

template <int D, int STORE>
DI void s5_scan32(unsigned* slab, int lane, float lr, float li, float& hr, float& hi_) {
    const f32x2_ lrv = {lr, lr}, liv = {-li, li};
    f32x2_ h = {hr, hi_};
#pragma unroll
    for (int i0 = 0; i0 < 32; i0 += 16) {
        unsigned w[16];
#pragma unroll
        for (int k = 0; k < 16; ++k) { const int t = D ? 31 - (i0 + k) : i0 + k; w[k] = slab[t * 68 + lane]; }
#pragma unroll
        for (int k = 0; k < 16; ++k) {
            const int t = D ? 31 - (i0 + k) : i0 + k;
            const f32x2_ bu = {bflo(w[k]), bfhi(w[k])};
            const f32x2_ hs = __builtin_shufflevector(h, h, 1, 0);
            const f32x2_ inner = __builtin_elementwise_fma(liv, hs, bu);
            h = __builtin_elementwise_fma(lrv, h, inner);
            if (STORE) slab[t * 68 + lane] = cvtpk(h[0], h[1]);
        }
    }
    hr = h[0]; hi_ = h[1];
    asm volatile("" ::: "memory");
}

DI void s5_load_dir(const Params& p, int pidx, int lane, float& lr, float& li, bf16x8 (&bR)[2], bf16x8 (&bI)[2]) {
    const int r32 = lane & 31, hi = lane >> 5;
    lr = ((const float*)(p.ws + OFF_LB))[(pidx + lane) * 2]; li = ((const float*)(p.ws + OFF_LB))[(pidx + lane) * 2 + 1];
#pragma unroll
    for (int pb = 0; pb < 2; ++pb) { bR[pb] = *(const bf16x8*)((const u16*)(p.ws + OFF_BBR) + (size_t)(pidx + pb * 32 + r32) * 16 + hi * 8);
        bI[pb] = *(const bf16x8*)((const u16*)(p.ws + OFF_BBI) + (size_t)(pidx + pb * 32 + r32) * 16 + hi * 8); }
}

template <int D>
DI void s5_p1_dir2(const Params& p, int l, int g0, int lane, const bf16x8 (&uaA)[4], const bf16x8 (&uaB)[4], unsigned* slabA, unsigned* slabB, float* epA, float* epB) {
    const int r32 = lane & 31, hi = lane >> 5;
    float lrA, liA, lrB, liB; bf16x8 bRA[2], bIA[2], bRB[2], bIB[2];
    s5_load_dir(p, ((l * 2 + D) * 16 + g0) * 64, lane, lrA, liA, bRA, bIA);
    s5_load_dir(p, ((l * 2 + D) * 16 + g0 + 1) * 64, lane, lrB, liB, bRB, bIB);
    const f32x2_ lrvA = {lrA, lrA}, livA = {-liA, liA}, lrvB = {lrB, lrB}, livB = {-liB, liB};
    f32x2_ hA = {0.f, 0.f}, hB = {0.f, 0.f};
#pragma unroll
    for (int sc = 0; sc < 4; ++sc) {
        __builtin_amdgcn_sched_barrier(0);
        s5_bu(uaA[D ? 3 - sc : sc], r32, hi, bRA, bIA, slabA);
        s5_bu(uaB[D ? 3 - sc : sc], r32, hi, bRB, bIB, slabB);
        __builtin_amdgcn_sched_barrier(0);
#pragma unroll
        for (int i0 = 0; i0 < 32; i0 += 8) {
            unsigned wA[8], wB[8];
#pragma unroll
            for (int k = 0; k < 8; ++k) { const int t = D ? 31 - (i0 + k) : i0 + k; wA[k] = slabA[t * 68 + lane]; wB[k] = slabB[t * 68 + lane]; }
#pragma unroll
            for (int k = 0; k < 8; ++k) {
                const f32x2_ buA = {bflo(wA[k]), bfhi(wA[k])}, buB = {bflo(wB[k]), bfhi(wB[k])};
                const f32x2_ hsA = __builtin_shufflevector(hA, hA, 1, 0), hsB = __builtin_shufflevector(hB, hB, 1, 0);
                const f32x2_ inA = __builtin_elementwise_fma(livA, hsA, buA), inB = __builtin_elementwise_fma(livB, hsB, buB);
                hA = __builtin_elementwise_fma(lrvA, hA, inA); hB = __builtin_elementwise_fma(lrvB, hB, inB);
            }
        }
        asm volatile("" ::: "memory");
    }
    epA[0] = hA[0]; epA[1] = hA[1]; epB[0] = hB[0]; epB[1] = hB[1];
}

DI void unit_s5_pass1(const Params& p, int l, int u, unsigned char* smem) {
    const int tid = otid(), wid = __builtin_amdgcn_readfirstlane(tid >> 6), lane = tid & 63, r32 = lane & 31, hi = lane >> 5;
    const u16* proj = (const u16*)(p.ws + OFF_PROJ);
    unsigned* slabA = (unsigned*)(smem + wid * 17408); unsigned* slabB = slabA + 8704 / 4;
    int r0, b, cidx; s5_unit_rows(u, r0, b, cidx);
    float* E = (float*)(p.ws + OFF_E);
    __syncthreads();
    bf16x8 ua[2][4];
#pragma unroll
    for (int gg = 0; gg < 2; ++gg)
#pragma unroll
        for (int sc = 0; sc < 4; ++sc) ua[gg][sc] = *(const bf16x8*)(proj + (size_t)(r0 + sc * 32 + r32) * NP + C_S5 + (wid * 2 + gg) * 16 + hi * 8);
    const int g0 = wid * 2;
    float* e0 = E + ((size_t)((0 * 4 + b) * 66 + cidx) * 16 + g0) * 128 + lane * 2;
    float* e1 = E + ((size_t)((1 * 4 + b) * 66 + cidx) * 16 + g0) * 128 + lane * 2;
    s5_p1_dir2<0>(p, l, g0, lane, ua[0], ua[1], slabA, slabB, e0, e0 + 128);
    s5_p1_dir2<1>(p, l, g0, lane, ua[0], ua[1], slabA, slabB, e1, e1 + 128);
}

DI void unit_s5_carry(const Params& p, int l, int u, unsigned* cnt) {
    const int tid = otid();
    const int id = u * 512 + tid;
    const int db = id >> 10, gp = id & 1023, d = db >> 2;
    const float* lb = (const float*)(p.ws + OFF_LB) + (size_t)(((l * 2 + d) * 16) * 64 + gp) * 2;
    float tr = lb[0], ti = lb[1];
#pragma unroll
    for (int i = 0; i < 7; ++i) { const float a = tr * tr - ti * ti, c = 2.f * tr * ti; tr = a; ti = c; }
    float* E = (float*)(p.ws + OFF_E) + ((size_t)db * 66 * 1024 + gp) * 2;
    float hr = 0.f, hi_ = 0.f; asm volatile("" : "+v"(hr), "+v"(hi_));
    for (int i0 = 0; i0 < 66; i0 += 11) {
        float er[11], ei[11];
#pragma unroll
        for (int k = 0; k < 11; ++k) { const int cj = d ? s5_rev_order(i0 + k) : i0 + k; const f32x2_ e = *(const f32x2_*)(E + (size_t)cj * 2048); er[k] = e[0]; ei[k] = e[1]; }
#pragma unroll
        for (int k = 0; k < 11; ++k) {
            const int cj = d ? s5_rev_order(i0 + k) : i0 + k;
            *(f32x2_*)(E + (size_t)cj * 2048) = (f32x2_){hr, hi_};
            const float nr = fmaf(tr, hr, fmaf(-ti, hi_, er[k])), ni = fmaf(tr, hi_, fmaf(ti, hr, ei[k])); hr = nr; hi_ = ni;
        }
    }
    asm volatile("s_waitcnt vmcnt(0)" ::: "memory");
    __syncthreads();
    if (tid == 0) { __threadfence(); __hip_atomic_fetch_add(cnt, 1u, __ATOMIC_RELEASE, __HIP_MEMORY_SCOPE_AGENT); }
}

template <int D>
DI void s5_p2_dir(const Params& p, int l, int g, int lane, const bf16x8 (&ua)[4], unsigned* slab, const float* ep, f32x4 (&Y)[8]) {
    const int r32 = lane & 31, hi = lane >> 5;
    float lr, li; bf16x8 bR[2], bI[2], cm[4];
    const int pidx = ((l * 2 + D) * 16 + g) * 64;
    s5_load_dir(p, pidx, lane, lr, li, bR, bI);
#pragma unroll
    for (int kb = 0; kb < 4; ++kb) cm[kb] = *(const bf16x8*)((const u16*)(p.ws + OFF_CM) + ((size_t)(pidx >> 6) * 16 + (lane & 15)) * 128 + kb * 32 + (lane >> 4) * 8);
    float hr = ep[0], hi_ = ep[1];
    const unsigned char* sb = (const unsigned char*)slab;
#pragma unroll
    for (int sc = 0; sc < 4; ++sc) {
        const int SC = D ? 3 - sc : sc;
        __builtin_amdgcn_sched_barrier(0);
        s5_bu(ua[SC], r32, hi, bR, bI, slab);
        __builtin_amdgcn_sched_barrier(0);
        s5_scan32<D, 1>(slab, lane, lr, li, hr, hi_);
#pragma unroll
        for (int rb = 0; rb < 2; ++rb)
#pragma unroll
            for (int kb = 0; kb < 4; ++kb) {
                const bf16x8 a = *(const bf16x8*)(sb + (16 * rb + (lane & 15)) * 272 + kb * 64 + (lane >> 4) * 16);
                Y[2 * SC + rb] = MFMA16(a, cm[kb], Y[2 * SC + rb]);
            }
        asm volatile("" ::: "memory");
    }
}

DI void unit_s5_pass2(const Params& p, int l, int u, unsigned char* smem, const unsigned* cnt) {
    const int tid = otid(), wid = __builtin_amdgcn_readfirstlane(tid >> 6), lane = tid & 63, r32 = lane & 31, hi = lane >> 5;
    const u16* proj = (const u16*)(p.ws + OFF_PROJ); u16* mix = (u16*)(p.ws + OFF_H);
    unsigned* slab = (unsigned*)(smem + wid * 8704);
    u16* gy = (u16*)(smem + 8 * 8704);
    int r0, b, cidx; s5_unit_rows(u, r0, b, cidx);
    const float* E = (const float*)(p.ws + OFF_E);
    if (tid == 0) { while (__hip_atomic_load(cnt, __ATOMIC_RELAXED, __HIP_MEMORY_SCOPE_AGENT) < 16u) __builtin_amdgcn_s_sleep(8); }
    __syncthreads();
    asm volatile("buffer_inv sc1\n\ts_waitcnt vmcnt(0)" ::: "memory");
#pragma unroll
    for (int gg = 0; gg < 2; ++gg) {
        const int g = wid * 2 + gg;
        bf16x8 ua[4];
#pragma unroll
        for (int sc = 0; sc < 4; ++sc) ua[sc] = *(const bf16x8*)(proj + (size_t)(r0 + sc * 32 + r32) * NP + C_S5 + g * 16 + hi * 8);
        f32x4 Y[8];
#pragma unroll
        for (int i = 0; i < 8; ++i) Y[i] = (f32x4){0.f, 0.f, 0.f, 0.f};
        s5_p2_dir<0>(p, l, g, lane, ua, slab, E + ((size_t)((0 * 4 + b) * 66 + cidx) * 16 + g) * 128 + lane * 2, Y);
        s5_p2_dir<1>(p, l, g, lane, ua, slab, E + ((size_t)((1 * 4 + b) * 66 + cidx) * 16 + g) * 128 + lane * 2, Y);
        int lnb = lane; asm volatile("" : "+v"(lnb));
        const int c = g * 16 + (lnb & 15); const float dsk = p.s5_d[l * 256 + c];
#pragma unroll
        for (int i = 0; i < 8; ++i)
#pragma unroll
            for (int r = 0; r < 4; ++r) {
                const int t = 16 * i + (lnb >> 4) * 4 + r;
                const float y = Y[i][r] + bf2f(proj[(size_t)(r0 + t) * NP + C_S5 + c]) * dsk;
                gy[t * 264 + c] = f2bf(gelu_tanh(y));
            }
    }
    __syncthreads();
    {
        const int tid2 = otid(), r32 = tid2 & 31, hi = (tid2 >> 5) & 1;
        const int n0 = wid * 32;
        const u16* W = (const u16*)(p.ws + OFF_WTGLU) + (size_t)l * 256 * 256;
        f32x16 acc[4];
#pragma unroll
        for (int i = 0; i < 4; ++i)
#pragma unroll
            for (int r = 0; r < 16; ++r) acc[i][r] = 0.f;
        bf16x8 bfr[16];
#pragma unroll
        for (int ks = 0; ks < 16; ++ks) bfr[ks] = *(const bf16x8*)(W + (size_t)(n0 + r32) * 256 + ks * 16 + hi * 8);
#pragma unroll
        for (int ks = 0; ks < 16; ++ks) {
#pragma unroll
            for (int i = 0; i < 4; ++i) { const bf16x8 af = *(const bf16x8*)(gy + (i * 32 + r32) * 264 + ks * 16 + hi * 8); acc[i] = MFMA32(bfr[ks], af, acc[i]); }
        }
#pragma unroll
        for (int i = 0; i < 4; ++i) {
            const int t = i * 32 + r32; const size_t row = (size_t)(r0 + t);
#pragma unroll
            for (int r4 = 0; r4 < 4; ++r4) {
                const int n = n0 + 8 * r4 + 4 * hi;
                const f32x4 bg = *(const f32x4*)(p.b_glu + l * 256 + n);
                const u32x2 yw = *(const u32x2*)(gy + t * 264 + n), gw = *(const u32x2*)(proj + row * NP + C_G + 512 + n);
                const float o0 = bflo(yw.x) * sigmoidf_(acc[i][4 * r4] + bg[0]) * siluf_(bflo(gw.x)), o1 = bfhi(yw.x) * sigmoidf_(acc[i][4 * r4 + 1] + bg[1]) * siluf_(bfhi(gw.x));
                const float o2 = bflo(yw.y) * sigmoidf_(acc[i][4 * r4 + 2] + bg[2]) * siluf_(bflo(gw.y)), o3 = bfhi(yw.y) * sigmoidf_(acc[i][4 * r4 + 3] + bg[3]) * siluf_(bfhi(gw.y));
                u32x2 w; w.x = cvtpk(S5_OUT_SCALE * o0, S5_OUT_SCALE * o1); w.y = cvtpk(S5_OUT_SCALE * o2, S5_OUT_SCALE * o3);
                *(u32x2*)(mix + row * DM + 512 + n) = w;
            }
        }
    }
}

constexpr int AT_V = 64 * 64 * 2, AT_K = 64 * 256, AT_LDS = 2 * AT_V + 2 * AT_K + 8 * 64 * 4;
#ifndef ATT_OUT_SCALE
#define ATT_OUT_SCALE 1.f
#endif
constexpr float AT_THR = 11.5f;
#define KSWZ(row, colB) ((row) * 256 + ((colB) ^ (((row) & 7) << 4)))
#define SBAR() __builtin_amdgcn_sched_barrier(0)
#define LSBAR() do {} while (0)
template <bool FIRST>
DI void partialSM(f32x16& p0, f32x16& p1, float& m_reg, f32x16& negm, float& alpha) {
    float pmax = p0[0];
#pragma unroll
    for (int r = 1; r < 16; ++r) pmax = fmaxf(pmax, p0[r]);
#pragma unroll
    for (int r = 0; r < 16; ++r) pmax = fmaxf(pmax, p1[r]);
    { auto rr = __builtin_amdgcn_permlane32_swap(__float_as_uint(pmax), __float_as_uint(pmax), false, false);
      pmax = fmaxf(__uint_as_float(rr[0]), __uint_as_float(rr[1])); }
    if (!FIRST && __builtin_expect(__all(pmax <= AT_THR), 1)) { alpha = 1.f; }
    else {
        const float delta = FIRST ? pmax : fmaxf(pmax, 0.f);
        alpha = FIRST ? 1.f : fexp2(-delta); m_reg += delta;
#pragma unroll
        for (int r = 0; r < 16; ++r) { p0[r] -= delta; p1[r] -= delta; negm[r] = -m_reg; }
    }
#pragma unroll
    for (int r = 0; r < 16; ++r) p0[r] = fexp2(p0[r]);
}
DI void finishSM(f32x16& p0, f32x16& p1, bf16x8& pa0, bf16x8& pa1, bf16x8& pa2, bf16x8& pa3) {
#pragma unroll
    for (int r = 0; r < 16; ++r) p1[r] = fexp2(p1[r]);
#define PK4(P, BASE, OUT) do { unsigned a0 = cvtpk(P[BASE + 0], P[BASE + 1]), a1 = cvtpk(P[BASE + 2], P[BASE + 3]);   \
    unsigned b0 = cvtpk(P[BASE + 4], P[BASE + 5]), b1 = cvtpk(P[BASE + 6], P[BASE + 7]);                              \
    auto r0 = __builtin_amdgcn_permlane32_swap(a0, b0, false, false); auto r1 = __builtin_amdgcn_permlane32_swap(a1, b1, false, false); \
    u32x4 w = {r0[0], r1[0], r0[1], r1[1]}; OUT = *reinterpret_cast<bf16x8*>(&w); } while (0)
    PK4(p0, 0, pa0); PK4(p0, 8, pa1); PK4(p1, 0, pa2); PK4(p1, 8, pa3);
#undef PK4
}
DI void qkt(f32x16& p0, f32x16& p1, const unsigned char* Ks, const bf16x8* qr, int r32, int hi, const f32x16& negm) {
    p0 = negm; p1 = negm;
#pragma unroll
    for (int d0 = 0; d0 < 6; ++d0) { const int cb = (d0 * 16 + hi * 8) * 2;
        const bf16x8 b0 = *reinterpret_cast<const bf16x8*>(Ks + KSWZ(r32, cb));
        const bf16x8 b1 = *reinterpret_cast<const bf16x8*>(Ks + KSWZ(32 + r32, cb));
        p0 = MFMA32(b0, qr[d0], p0);
        p1 = MFMA32(b1, qr[d0], p1); }
}
DI int v_st(int k, int c) { const int kk = (k & ~0xC) | ((k & 4) << 1) | ((k & 8) >> 1); return ((kk >> 3) * 2 + (c >> 5)) * 512 + ((kk & 7) * 32 + (c & 31)) * 2; }
DI int v_rd_base(int lane) { return ((lane & 3) << 3) | (((lane >> 2) & 3) << 6) | (((lane >> 4) & 1) << 5) | (((lane >> 5) & 1) << 8); }
constexpr int v_rd_off(int d0, int ks, int half) { return d0 * 512 + ks * 2048 + half * 1024; }
template <int OFF> DI s16x4 tr_read(int vb) { s16x4 r; asm volatile("ds_read_b64_tr_b16 %0, %1 offset:%2" : "=&v"(r) : "v"(vb), "i"(OFF) : "memory"); return r; }
template <int D0> DI void pv_one(f32x16& od, int vb, bf16x8 pa0, bf16x8 pa1, bf16x8 pa2, bf16x8 pa3) {
    const s16x4 l0 = tr_read<v_rd_off(D0, 0, 0)>(vb), h0 = tr_read<v_rd_off(D0, 0, 1)>(vb), l1 = tr_read<v_rd_off(D0, 1, 0)>(vb), h1 = tr_read<v_rd_off(D0, 1, 1)>(vb);
    const s16x4 l2 = tr_read<v_rd_off(D0, 2, 0)>(vb), h2 = tr_read<v_rd_off(D0, 2, 1)>(vb), l3 = tr_read<v_rd_off(D0, 3, 0)>(vb), h3 = tr_read<v_rd_off(D0, 3, 1)>(vb);
    asm volatile("s_waitcnt lgkmcnt(0)" ::: "memory"); SBAR();
#define PK(L, H) (bf16x8){L[0], L[1], L[2], L[3], H[0], H[1], H[2], H[3]}
    od = MFMA32(pa0, PK(l0, h0), od);
    od = MFMA32(pa1, PK(l1, h1), od);
    od = MFMA32(pa2, PK(l2, h2), od);
    od = MFMA32(pa3, PK(l3, h3), od);
#undef PK
}
DI void pv_d0(f32x16* o, int vb, bf16x8 pa0, bf16x8 pa1, bf16x8 pa2, bf16x8 pa3) {
    pv_one<0>(o[0], vb, pa0, pa1, pa2, pa3); pv_one<1>(o[1], vb, pa0, pa1, pa2, pa3);
    const bf16x8 ones = {0x3F80, 0x3F80, 0x3F80, 0x3F80, 0x3F80, 0x3F80, 0x3F80, 0x3F80};
    o[2] = MFMA32(pa0, ones, o[2]); o[2] = MFMA32(pa1, ones, o[2]); o[2] = MFMA32(pa2, ones, o[2]); o[2] = MFMA32(pa3, ones, o[2]);
}

DI void attn_unit(const u16* __restrict__ Qb, const u16* __restrict__ Kh, const u16* __restrict__ Vh, int nkeys, int row0, int h, const Params& p, unsigned char* lds) {
    const int tid = otid(), wid = __builtin_amdgcn_readfirstlane(tid >> 6), lane = tid & 63, r32 = lane & 31, hi = lane >> 5;
    unsigned char* V_lds = lds; unsigned char* K_lds = lds + 2 * AT_V;
    float* wsl = (float*)(lds + 2 * AT_V + 2 * AT_K) + wid * 64; float* al_l = wsl + 32;
    float m_reg = 0.f; f32x16 o[3], negm; bf16x8 qr[6];
#pragma unroll
    for (int r = 0; r < 16; ++r) negm[r] = 0.f;
#pragma unroll
    for (int d = 0; d < 3; ++d)
#pragma unroll
        for (int r = 0; r < 16; ++r) o[d][r] = 0.f;
    const u16* Qw = Qb + (size_t)(wid * 32 + r32) * 96 + hi * 8;
#pragma unroll
    for (int d0 = 0; d0 < 6; ++d0) qr[d0] = *(const bf16x8*)(Qw + d0 * 16);
    const int vst = v_st(tid >> 3, (tid & 7) * 8);
    const int kc0 = tid, kc1 = 512 + (tid & 255);
    const int kst0 = KSWZ(kc0 / 12, (kc0 % 12) * 16), kst1 = KSWZ(kc1 / 12, (kc1 % 12) * 16);
    const bool k2 = tid < 256;
    const int vb0 = (int)(uintptr_t)V_lds + v_rd_base(lane);
    struct { bf16x8 vs, ks0, ks1; } sr_[2];
#define SLOAD(i, k0) do { sr_[i].vs = *(const bf16x8*)(Vh + (size_t)(k0) * 64 + tid * 8); sr_[i].ks0 = *(const bf16x8*)(Kh + (size_t)(k0) * 96 + kc0 * 8); \
    sr_[i].ks1 = *(const bf16x8*)(Kh + (size_t)(k0) * 96 + kc1 * 8); } while (0)
#define SWRITE(b, i) do { *(bf16x8*)(V_lds + (b) * AT_V + vst) = sr_[i].vs; *(bf16x8*)(K_lds + (b) * AT_K + kst0) = sr_[i].ks0; \
    if (k2) *(bf16x8*)(K_lds + (b) * AT_K + kst1) = sr_[i].ks1; } while (0)
#define SWAIT() asm volatile("s_waitcnt vmcnt(3)" ::: "memory")
#define RESC(a) do { if (__any((a) < 1.f)) { if (hi == 0) al_l[r32] = (a); asm volatile("s_waitcnt lgkmcnt(0)" ::: "memory"); \
    _Pragma("unroll") for (int d = 0; d < 3; ++d) _Pragma("unroll") for (int r = 0; r < 16; ++r) o[d][r] *= al_l[crow(r, hi)]; } } while (0)
    f32x16 pA0, pA1, pB0, pB1; float alA, alB; bf16x8 pa0, pa1, pa2, pa3; const int NT = nkeys / 64;
    constexpr int SE = 0, SO = 1;
    __syncthreads();
    SLOAD(SE, 0); asm volatile("s_waitcnt vmcnt(0)" ::: "memory"); SWRITE(0, SE); __syncthreads();
    qkt(pA0, pA1, K_lds, qr, r32, hi, negm); partialSM<true>(pA0, pA1, m_reg, negm, alA);
    SLOAD(SO, 64); if (2 < NT) SLOAD(SE, 128);
    SWAIT(); SWRITE(1, SO); __syncthreads();
    for (int j = 1; j + 1 < NT; j += 2) {
        LSBAR(); qkt(pB0, pB1, K_lds + AT_K, qr, r32, hi, negm);
        finishSM(pA0, pA1, pa0, pa1, pa2, pa3); LSBAR();
        SLOAD(SO, (j + 2) * 64); LSBAR();
        pv_d0(o, vb0, pa0, pa1, pa2, pa3); partialSM<false>(pB0, pB1, m_reg, negm, alB);
        __syncthreads(); SWAIT(); SWRITE(0, SE);
        RESC(alB); __syncthreads();
        LSBAR(); qkt(pA0, pA1, K_lds, qr, r32, hi, negm);
        finishSM(pB0, pB1, pa0, pa1, pa2, pa3); LSBAR();
        if (j + 3 < NT) SLOAD(SE, (j + 3) * 64); LSBAR();
        pv_d0(o, vb0 + AT_V, pa0, pa1, pa2, pa3); partialSM<false>(pA0, pA1, m_reg, negm, alA);
        __syncthreads(); SWAIT(); SWRITE(1, SO);
        RESC(alA); __syncthreads();
    }
    LSBAR(); qkt(pB0, pB1, K_lds + AT_K, qr, r32, hi, negm);
    finishSM(pA0, pA1, pa0, pa1, pa2, pa3); LSBAR();
    pv_d0(o, vb0, pa0, pa1, pa2, pa3); partialSM<false>(pB0, pB1, m_reg, negm, alB);
    __syncthreads(); RESC(alB);
    finishSM(pB0, pB1, pa0, pa1, pa2, pa3); LSBAR();
    pv_d0(o, vb0 + AT_V, pa0, pa1, pa2, pa3);
    const u16* proj = (const u16*)(p.ws + OFF_PROJ); u16* mix = (u16*)(p.ws + OFF_H);
#pragma unroll
    for (int r = 0; r < 16; ++r) {
        const int orow = row0 + wid * 32 + crow(r, hi); const float rl = __builtin_amdgcn_rcpf(o[2][r]);
#pragma unroll
        for (int d0 = 0; d0 < 2; ++d0) {
            const int c = h * 64 + d0 * 32 + r32;
            const float gt = bf2f(proj[(size_t)orow * NP + C_G + c]);
            mix[(size_t)orow * DM + c] = f2bf(ATT_OUT_SCALE * o[d0][r] * rl * siluf_(gt));
        }
    }
#undef SLOAD
#undef SWRITE
#undef SWAIT
#undef RESC
}
#define XB_TMO      128
#define XB_XCNT(j)  (256  + 64 * (j))
#define XB_XSUB(j)  (1280 + 64 * (j))
#define XB_XGEN(j)  (2304 + 64 * (j))
#define XB_TOP      3328
#define XB_TOPGEN   3392
#define XCD_BAR_WORDS 3456
#define XB_SPIN_CAP (1u << 18)
#define LAS __attribute__((address_space(3)))

__device__ __forceinline__ unsigned xb_ld(unsigned* p)              { return __hip_atomic_load(p, __ATOMIC_RELAXED, __HIP_MEMORY_SCOPE_AGENT); }
__device__ __forceinline__ unsigned xb_add(unsigned* p, unsigned v) { return __hip_atomic_fetch_add(p, v, __ATOMIC_RELAXED, __HIP_MEMORY_SCOPE_AGENT); }
__device__ __forceinline__ unsigned xb_xcc_id() { return (unsigned)__builtin_amdgcn_s_getreg((3 << 11) | 20) & 0xFu; }
#define XB_SPIN(cond, bar) do { unsigned _sp = 0; while (cond) { __builtin_amdgcn_s_sleep(1); \
    if ((++_sp & 255u) == 0u) { if (xb_ld(&(bar)[XB_TMO])) break; if (_sp > XB_SPIN_CAP) { atomicAdd(&(bar)[XB_TMO], 1u); break; } } } } while (0)

struct XcdBarrier {
    unsigned* bar; unsigned x;
    volatile LAS unsigned* st;
};

__device__ __forceinline__ XcdBarrier xcd_barrier_post(unsigned* bar, volatile LAS unsigned* st) {
    XcdBarrier b; b.bar = bar; b.x = xb_xcc_id(); b.st = st;
    if (threadIdx.x == 0) (void)xb_add(&bar[XB_XCNT(b.x)], 1u);
    return b;
}
__device__ __forceinline__ void xcd_barrier_complete(unsigned* bar, unsigned x, unsigned& nloc, unsigned& nx) {
    const unsigned G = gridDim.x * gridDim.y * gridDim.z;
    unsigned sum, cnt, mine, sp = 0u;
    for (;;) {
        sum = 0u; cnt = 0u; mine = 0u;
#pragma unroll
        for (unsigned j = 0; j < 16; ++j) { const unsigned c = xb_ld(&bar[XB_XCNT(j)]); sum += c; cnt += (c > 0u) ? 1u : 0u; mine = (j == x) ? c : mine; }
        if (sum == G) break;
        __builtin_amdgcn_s_sleep(1);
        if ((++sp & 255u) == 0u) { if (xb_ld(&bar[XB_TMO])) break; if (sp > XB_SPIN_CAP) { atomicAdd(&bar[XB_TMO], 1u); break; } }
    }
    nloc = mine > 0u ? mine : 1u; nx = cnt > 0u ? cnt : 1u;
}

__device__ __forceinline__ void xcd_barrier(const XcdBarrier& b) {
    asm volatile("s_waitcnt vmcnt(0)" ::: "memory");
    __syncthreads();
    if (threadIdx.x == 0) {
        unsigned* bar = b.bar;
        __builtin_amdgcn_s_waitcnt(0);
        unsigned nloc = b.st[0], nx = b.st[1];
        if (nloc == 0u) { xcd_barrier_complete(bar, b.x, nloc, nx); b.st[0] = nloc; b.st[1] = nx; }
        const unsigned old = xb_add(&bar[XB_XSUB(b.x)], 1u);
        const unsigned gen = old / nloc;
        if (old + 1u == (gen + 1u) * nloc) {
            __builtin_amdgcn_fence(__ATOMIC_RELEASE, "agent");
            asm volatile("s_waitcnt vmcnt(0)" ::: "memory");
            const unsigned og = xb_add(&bar[XB_TOP], 1u);
            const unsigned tg = og / nx;
            if (og + 1u == (tg + 1u) * nx) xb_add(&bar[XB_TOPGEN], 1u);
            else XB_SPIN(xb_ld(&bar[XB_TOPGEN]) == tg, bar);
            __builtin_amdgcn_fence(__ATOMIC_ACQUIRE, "agent");
            xb_add(&bar[XB_XGEN(b.x)], 1u);
            asm volatile("s_waitcnt vmcnt(0)" ::: "memory");
        } else {
            XB_SPIN(xb_ld(&bar[XB_XGEN(b.x)]) == gen, bar);
            __builtin_amdgcn_fence(__ATOMIC_ACQUIRE, "agent");
            asm volatile("s_waitcnt vmcnt(0)" ::: "memory");
        }
    }
    __syncthreads();
}

#ifndef RC_S5
#define RC_S5 1
#endif
#ifndef RC_SGU
#define RC_SGU 1
#endif
#ifndef RC_MLA
#define RC_MLA 1
#endif
#ifndef RC_POOL
#define RC_POOL 1
#endif
DI void phase_c(const Params& p, int l, unsigned char* smem) {
    const int last = (l == 1);
    const int n_g = last ? 8 : 40, n_s5c = 8, n_sguc = last ? 0 : 8, n_mlac = 16, n_poolc = last ? 0 : 16;
    const int total = n_g + 256 + 256 + 512 + 512 + n_s5c + n_sguc + n_mlac + n_poolc;
    unsigned* queue = (unsigned*)(p.ws + OFF_CNT) + 32 + l * 16;
    unsigned* gdone = (unsigned*)(p.ws + OFF_CNT) + 8 + l * 4;
    volatile LAS int* nx = (volatile LAS int*)(smem + LDS_BYTES - 4);
    int u = blockIdx.x;
    while (u < total) {
        int nxt = 0;
        if (threadIdx.x == 0) nxt = (int)gridDim.x + (int)__hip_atomic_fetch_add(queue, 1u, __ATOMIC_RELAXED, __HIP_MEMORY_SCOPE_AGENT);
        int v = u;
        if (v < n_g) unit_gemm_ctx(p, l, v, smem, gdone);
        else if ((v -= n_g) < 256) unit_s5_pass1(p, l, v, smem);
        else if ((v -= 256) < 256) unit_sgu(p, l, v, smem);
        else if ((v -= 256) < 512) unit_mla(p, l, v, smem);
        else if ((v -= 512) < 512) unit_pool(p, l, v, smem);
        else {
            v -= 512;
            if (threadIdx.x == 0) { while (__hip_atomic_load(gdone, __ATOMIC_RELAXED, __HIP_MEMORY_SCOPE_AGENT) < (unsigned)n_g) __builtin_amdgcn_s_sleep(8); }
            __syncthreads();
            asm volatile("buffer_inv sc1\n\ts_waitcnt vmcnt(0)" ::: "memory");
            if (v < n_s5c) unit_s5_pass1(p, l, 256 + v, smem);
            else if ((v -= n_s5c) < n_sguc) unit_sgu(p, l, 256 + v, smem);
            else if ((v -= n_sguc) < n_mlac) unit_mla(p, l, 512 + v, smem);
            else unit_pool(p, l, 512 + (v - n_mlac), smem);
        }
        if (threadIdx.x == 0) nx[0] = nxt;
        __syncthreads();
        u = __builtin_amdgcn_readfirstlane(nx[0]);
    }
}

#ifndef RD_ATT
#define RD_ATT 1
#endif
#ifndef RD_S5
#define RD_S5 1
#endif
DI void phase_d(const Params& p, int l, unsigned char* smem) {
    const int last = (l == 1);
    const u16* Qg = (const u16*)(p.ws + OFF_Q); const u16* Kg = (const u16*)(p.ws + OFF_K); const u16* Vg = (const u16*)(p.ws + OFF_V);
    unsigned* cnt = (unsigned*)(p.ws + OFF_CNT) + l * 16;
    for (int uu = blockIdx.x; uu < 16 + 512; uu += gridDim.x) {
        if (uu < 16) { unit_s5_carry(p, l, uu, cnt); continue; }
        const int u = uu - 16;
        const int bh = (u & 7) + 8 * (u >> 8), qb = (u >> 3) & 31, b = bh >> 2, h = bh & 3;
        for (int q = 0; q < RD_ATT; ++q) attn_unit(Qg + ((size_t)bh * SKV + 256 + qb * 256) * 96, Kg + (size_t)bh * SKV * 96, Vg + (size_t)bh * SKV * 64, SKV, b * SEQ + qb * 256, h, p, smem);
    }
    const int n_cs5 = last ? 0 : 8, n_catt = last ? 0 : 16, n_ge = last ? 0 : 16;
    const int total = n_cs5 + n_catt + 256 + n_ge;
    unsigned* queue = (unsigned*)(p.ws + OFF_CNT) + 36 + l * 16;
    unsigned* mixdone = (unsigned*)(p.ws + OFF_CNT) + 10;
    volatile LAS int* nx = (volatile LAS int*)(smem + LDS_BYTES - 4);
    int u = blockIdx.x;
    while (u < total) {
        int nxt = 0;
        if (threadIdx.x == 0) nxt = (int)gridDim.x + (int)__hip_atomic_fetch_add(queue, 1u, __ATOMIC_RELAXED, __HIP_MEMORY_SCOPE_AGENT);
        int v = u;
        if (v < n_cs5) { unit_s5_pass2(p, l, 256 + v, smem, cnt); publish_unit(mixdone); }
        else if ((v -= n_cs5) < n_catt) {
            const int b = v >> 2, h = v & 3;
            attn_unit(Qg + (size_t)v * SKV * 96, Kg + (size_t)v * SKV * 96, Vg + (size_t)v * SKV * 64, CTXL, NLAT + b * CTXL, h, p, smem);
            publish_unit(mixdone);
        }
        else if ((v -= n_catt) < 256) { for (int q = 0; q < RD_S5; ++q) unit_s5_pass2(p, l, v, smem, cnt); }
        else { v -= 256; wait_units(mixdone, 24u); unit_gemm_one((const u16*)(p.ws + OFF_H), (const u16*)(p.ws + OFF_WTOUT), (u16*)(p.ws + OFF_Y), DM, 128 + (v >> 2), v & 3, smem); }
        if (threadIdx.x == 0) nx[0] = nxt;
        __syncthreads();
        u = __builtin_amdgcn_readfirstlane(nx[0]);
    }
}

DI void gsync(const XcdBarrier& b) { xcd_barrier(b); }
DI void gsync_cg(cg::grid_group& g) {
    asm volatile("s_waitcnt vmcnt(0) lgkmcnt(0)" ::: "memory");
    g.sync();
    asm volatile("buffer_inv sc1\n\ts_waitcnt vmcnt(0)" ::: "memory");
}
#ifndef REP_SYNC
#define REP_SYNC 0
#endif
#ifndef REP_W
#define REP_W 1
#endif
#ifndef REP_A
#define REP_A 1
#endif
#ifndef REP_B
#define REP_B 1
#endif
#ifndef REP_C
#define REP_C 1
#endif
#ifndef REP_D
#define REP_D 1
#endif
#ifndef REP_E
#define REP_E 1
#endif
#ifndef REP_F
#define REP_F 1
#endif
__global__ void __launch_bounds__(512) fwd_megakernel(Params p) {
    extern __shared__ __attribute__((aligned(16))) unsigned char smem[];
    cg::grid_group grid = cg::this_grid();
    volatile LAS unsigned* xst = (volatile LAS unsigned*)(smem + LDS_BYTES - 16);
    if (threadIdx.x < 4) xst[threadIdx.x] = 0u;
    __syncthreads();
    const XcdBarrier xb = xcd_barrier_post((unsigned*)(p.ws + OFF_BAR), xst);
    u16* hb = (u16*)(p.ws + OFF_H); u16* proj = (u16*)(p.ws + OFF_PROJ); u16* yb = (u16*)(p.ws + OFF_Y);
    if (p.ws == nullptr) gsync_cg(grid);
    for (int rep = 0; rep < REP_W; ++rep) { phase_w(p, smem); gsync(xb); }
    for (int rep = 0; rep < REP_A; ++rep) { phase_a(p, smem); gsync(xb); }
    for (int rep = 0; rep < REP_SYNC; ++rep) gsync(xb);
    for (int l = 0; l < 2; ++l) {
        for (int rep = 0; rep < REP_B; ++rep) { phase_gemm(hb, (const u16*)(p.ws + OFF_WTIN) + (size_t)l * NP * DM, proj, NLAT, NP, NP, smem); gsync(xb); }
        for (int rep = 0; rep < REP_C; ++rep) { phase_c(p, l, smem); gsync(xb); }
        for (int rep = 0; rep < REP_D; ++rep) { phase_d(p, l, smem); gsync(xb); }
        for (int rep = 0; rep < REP_E; ++rep) { phase_gemm(hb, (const u16*)(p.ws + OFF_WTOUT) + (size_t)l * DM * DM, yb, NLAT, DM, DM, smem); gsync(xb); }
        if (l == 0) { for (int rep = 0; rep < REP_F; ++rep) { phase_f(p, l, smem); gsync(xb); } } else phase_f(p, l, smem);
    }
}

extern "C" void kernel_launch(void* const* d_in, const int* in_sizes, int n_in, void* d_out, int out_size, void* d_ws, size_t ws_size, hipStream_t stream) {
    static int grid_blocks = 0;
    if (grid_blocks == 0) {
        if (n_in != 30 || out_size != NLAT * DM || ws_size < WS_END) { fprintf(stderr, "kernel_launch: unexpected shapes (n_in %d out %d ws %zu need %zu)\n", n_in, out_size, ws_size, (size_t)WS_END); grid_blocks = -1; return; }
        int dev = 0, cus = 0, per_cu = 0;
        hipGetDevice(&dev);
        hipDeviceGetAttribute(&cus, hipDeviceAttributeMultiprocessorCount, dev);
        if (hipFuncSetAttribute((const void*)fwd_megakernel, hipFuncAttributeMaxDynamicSharedMemorySize, LDS_BYTES) != hipSuccess) { fprintf(stderr, "kernel_launch: hipFuncSetAttribute failed\n"); grid_blocks = -1; return; }
        hipOccupancyMaxActiveBlocksPerMultiprocessor(&per_cu, (const void*)fwd_megakernel, 512, LDS_BYTES);
        if (per_cu < 1) { fprintf(stderr, "kernel_launch: occupancy query says %d blocks per CU\n", per_cu); per_cu = 1; }
        grid_blocks = cus * per_cu;
    }
    if (grid_blocks < 0) return;
    if (hipMemsetAsync((char*)d_ws + OFF_BAR, 0, BAR_BYTES, stream) != hipSuccess) { fprintf(stderr, "kernel_launch: hipMemsetAsync failed\n"); return; }
    Params p{};
    const float** pp = (const float**)&p;
    for (int i = 0; i < 30; ++i) pp[i] = (const float*)d_in[i];
    p.out = (float*)d_out; p.ws = (unsigned char*)d_ws;
    void* args[] = {&p};
    hipError_t e = hipLaunchCooperativeKernel((const void*)fwd_megakernel, dim3(grid_blocks), dim3(512), args, LDS_BYTES, stream);
    if (e != hipSuccess) fprintf(stderr, "cooperative launch failed: %s (grid %d)\n", hipGetErrorString(e), grid_blocks);
}
```

```cpp
#include <hip/hip_runtime.h>
#include <hip/hip_cooperative_groups.h>
#include <cstdio>
#include <cstdint>
namespace cg = cooperative_groups;
namespace pg8 {
#define PG8_LAS __attribute__((address_space(3)))
typedef unsigned short bf16_t;
typedef short bf16x8 __attribute__((ext_vector_type(8)));
typedef float f32x4 __attribute__((ext_vector_type(4)));
typedef unsigned u32x4 __attribute__((ext_vector_type(4)));
constexpr int BM = 256, BK = 64, HALF = 128, HTB = HALF * BK * 2  , STAGE_BYTES = 8 * HTB, NXCD = 8, WGM = 8;

__host__ __device__ __forceinline__ int lds_byte(int r, int c) { const int st = (r >> 4) * 2 + (c >> 5), rr = r & 15, cc = c & 31, ob = rr * 64 + cc * 2; return st * 1024 + (ob ^ (((ob >> 9) & 1) << 5)); }
__host__ __device__ __forceinline__ void stage_rc(int b, int& R, int& C) { const int st = b / 1024, sb = b % 1024, swz = sb ^ (((sb >> 9) & 1) << 5); R = (st >> 1) * 16 + swz / 64; C = (st & 1) * 32 + (swz % 64) / 2; }
__host__ __device__ __forceinline__ int perm32(int rho) { const int n = rho >> 4, i = rho & 15; return 8 * (i >> 2) + 4 * n + (i & 3); }

struct Unit { int pm, pn; };
struct Gemm { const bf16_t* A; const bf16_t* Bt; int M, N, K; };

struct StaticOrder {
    int nM, nN, nwg, G, c;
    __host__ __device__ void init(int M, int N, int G_, int c_) { nM = M / BM; nN = N / BM; nwg = nM * nN; G = G_; c = c_; }
    __host__ __device__ bool next(int i, Unit& u) const {
        const long L = (long)i * G + c; if (L >= nwg) return false;
        int wgid = (int)L; { const int q = nwg / NXCD, r = nwg % NXCD, xcd = wgid % NXCD, off = wgid / NXCD; wgid = (xcd < r ? xcd * (q + 1) : r * (q + 1) + (xcd - r) * q) + off; }
        const int nig = WGM * nN, gid = wgid / nig, fm = gid * WGM, gsz = (nM - fm) < WGM ? (nM - fm) : WGM;
        u.pm = fm + ((wgid % nig) % gsz); u.pn = (wgid % nig) / gsz; return true;
    }
    __device__ __forceinline__ void a_ready(const Unit&) const {}
    __device__ __forceinline__ void done(const Unit&) const {}
};
typedef float f32x2v __attribute__((ext_vector_type(2))); typedef __bf16 bf16x2v __attribute__((ext_vector_type(2)));
__device__ __forceinline__ unsigned cvt_pk_bf16(float lo, float hi) { const f32x2v v = {lo, hi}; const bf16x2v b = __builtin_convertvector(v, bf16x2v); return __builtin_bit_cast(unsigned, b); }
template <class Epi, class Sched, bool STAMP = false>
__device__ __forceinline__ void gemm_phase(PG8_LAS unsigned char* lds, const Gemm g, const Sched& S, const Epi& E, unsigned long long* stamps) {
    int tid = threadIdx.x; asm volatile("" : "+v"(tid)); const int wid = __builtin_amdgcn_readfirstlane(tid >> 6), lane = tid & 63, wr = wid >> 2, wc = wid & 3, fr = lane & 15, fq = lane >> 4;
    const int K = g.K, nt = K / BK;
    int ts_lo = 0, ts_hi = 0, nts = 0; const unsigned long long rt_entry = STAMP ? (unsigned long long)wall_clock64() : 0ull;
#define PG8_STAMP() do { if (STAMP && wid == 0 && nts < 64) { const unsigned long long _c = (unsigned long long)clock64(); \
        ts_lo = (lane == nts) ? (int)(unsigned)_c : ts_lo; ts_hi = (lane == nts) ? (int)(unsigned)(_c >> 32) : ts_hi; ++nts; } } while (0)
    PG8_STAMP();
    unsigned voffA[2], voffB[2];
#pragma unroll
    for (int i = 0; i < 2; ++i) { int R, C; stage_rc(tid * 16 + i * 8192, R, C); const int Rb = Epi::PERM ? ((R & ~31) + perm32(R & 31)) : R;
        voffA[i] = (unsigned)(R * K + C) * 2u; voffB[i] = (unsigned)(Rb * K + C) * 2u; }
    const size_t kstep = (size_t)(BK * 2);
    const size_t hstep = (size_t)HALF * K * 2;
    const size_t tstep = 2 * hstep;
    const unsigned ldsw = (unsigned)wid * 1024u;
    const int aoff = lds_byte(wr * 64 + fr, fq * 8), boff = lds_byte(wc * 32 + fr, fq * 8);
#define PG8_SA(b, h) (((b) * 2 + (h)) * HTB)
#define PG8_SB(b, h) ((4 + (b) * 2 + (h)) * HTB)
#define PG8_STAGE(bufoff, gbase, voff) do { _Pragma("unroll") for (int _i = 0; _i < 2; ++_i) \
        __builtin_amdgcn_global_load_lds((const unsigned*)((const char*)(gbase) + (voff)[_i]), (PG8_LAS unsigned*)(lds + (bufoff) + ldsw + _i * 8192), 16, 0, 0); } while (0)
#define PG8_LDA(dst, b, h) do { _Pragma("unroll") for (int m = 0; m < 4; ++m) _Pragma("unroll") for (int k = 0; k < 2; ++k) dst[m][k] = *(const PG8_LAS bf16x8*)(lds + PG8_SA(b, h) + aoff + m * 2048 + k * 1024); } while (0)
#define PG8_LDB(dst, b, h) do { _Pragma("unroll") for (int n = 0; n < 2; ++n) _Pragma("unroll") for (int k = 0; k < 2; ++k) dst[n][k] = *(const PG8_LAS bf16x8*)(lds + PG8_SB(b, h) + boff + n * 2048 + k * 1024); } while (0)
#define PG8_MMA(ai, bj, At, Bt) do { __builtin_amdgcn_s_setprio(1); _Pragma("unroll") for (int m = 0; m < 4; ++m) _Pragma("unroll") for (int n = 0; n < 2; ++n) _Pragma("unroll") for (int k = 0; k < 2; ++k) \
        acc[ai][bj][m][n] = __builtin_amdgcn_mfma_f32_16x16x32_bf16(Bt[n][k], At[m][k], acc[ai][bj][m][n], 0, 0, 0); __builtin_amdgcn_s_setprio(0); } while (0)
#define PG8_WAIT_V(n) asm volatile("s_waitcnt vmcnt(" #n ")" ::: "memory")
#define PG8_WAIT_L(n) asm volatile("s_waitcnt lgkmcnt(" #n ")" ::: "memory")
#define PG8_BAR __builtin_amdgcn_s_barrier()
#define PG8_SCHED __builtin_amdgcn_sched_barrier(0)
    Unit cur, nxt; int ui = 0;
    if (!S.next(0, cur)) return;
    f32x4 acc[2][2][4][2];
#pragma unroll
    for (int a = 0; a < 2; ++a)
#pragma unroll
        for (int b = 0; b < 2; ++b)
#pragma unroll
            for (int m = 0; m < 4; ++m)
#pragma unroll
                for (int n = 0; n < 2; ++n) acc[a][b][m][n] = (f32x4){0.f, 0.f, 0.f, 0.f};
    bf16x8 At[4][2], B0[2][2], B1[2][2];
    const char* cA = (const char*)g.A + (size_t)cur.pm * tstep; const char* cB = (const char*)g.Bt + (size_t)cur.pn * tstep;
    S.a_ready(cur);
    PG8_STAGE(PG8_SB(0, 0), cB, voffB); PG8_STAGE(PG8_SA(0, 0), cA, voffA); PG8_STAGE(PG8_SB(0, 1), cB + hstep, voffB); PG8_STAGE(PG8_SA(0, 1), cA + hstep, voffA);
    if (wr == 1) PG8_BAR;
    PG8_WAIT_V(4); PG8_BAR;
    PG8_STAGE(PG8_SB(1, 0), cB + kstep, voffB); PG8_STAGE(PG8_SA(1, 0), cA + kstep, voffA); PG8_STAGE(PG8_SB(1, 1), cB + hstep + kstep, voffB);
    PG8_WAIT_V(6); PG8_BAR;
    PG8_STAMP();
    for (;;) {
        const bool has_next = S.next(ui + 1, nxt);
        const char* nA = has_next ? (const char*)g.A + (size_t)nxt.pm * tstep : cA; const char* nB = has_next ? (const char*)g.Bt + (size_t)nxt.pn * tstep : cB;
        for (int t = 0; t < nt; t += 2) {
            const bool last = (t == nt - 2);
            const char* a1 = cA + (size_t)(t + 1) * kstep;
            const char* a2 = last ? nA : cA + (size_t)(t + 2) * kstep; const char* b2 = last ? nB : cB + (size_t)(t + 2) * kstep;
            const char* a3 = a2 + kstep; const char* b3 = b2 + kstep;
            if (last && has_next) S.a_ready(nxt);
            PG8_LDB(B0, 0, 0); PG8_SCHED; PG8_LDA(At, 0, 0); PG8_STAGE(PG8_SA(1, 1), a1 + hstep, voffA);
            PG8_WAIT_L(8); PG8_BAR; PG8_WAIT_L(0); PG8_MMA(0, 0, At, B0); PG8_BAR; PG8_SCHED;
            PG8_LDB(B1, 0, 1); PG8_STAGE(PG8_SB(0, 0), b2, voffB);
            PG8_BAR; PG8_WAIT_L(0); PG8_MMA(0, 1, At, B1); PG8_BAR;
            PG8_LDA(At, 0, 1); PG8_STAGE(PG8_SA(0, 0), a2, voffA);
            PG8_BAR; PG8_WAIT_L(0); PG8_MMA(1, 0, At, B0); PG8_BAR; PG8_SCHED;
            PG8_STAGE(PG8_SB(0, 1), b2 + hstep, voffB);
            PG8_WAIT_V(6); PG8_BAR; PG8_MMA(1, 1, At, B1); PG8_BAR;
            PG8_LDB(B0, 1, 0); PG8_SCHED; PG8_LDA(At, 1, 0); PG8_STAGE(PG8_SA(0, 1), a2 + hstep, voffA);
            PG8_WAIT_L(8); PG8_BAR; PG8_WAIT_L(0); PG8_MMA(0, 0, At, B0); PG8_BAR; PG8_SCHED;
            PG8_LDB(B1, 1, 1); PG8_STAGE(PG8_SB(1, 0), b3, voffB);
            PG8_BAR; PG8_WAIT_L(0); PG8_MMA(0, 1, At, B1); PG8_BAR;
            PG8_LDA(At, 1, 1); PG8_STAGE(PG8_SA(1, 0), a3, voffA);
            PG8_BAR; PG8_WAIT_L(0); PG8_MMA(1, 0, At, B0); PG8_BAR; PG8_SCHED;
            PG8_STAGE(PG8_SB(1, 1), b3 + hstep, voffB);
            PG8_WAIT_V(6); PG8_BAR; PG8_MMA(1, 1, At, B1); PG8_BAR;
        }
        PG8_STAMP();
        if constexpr (!Epi::AFTER_DRAIN) { E(acc, cur, wr, wc, fr, fq); S.done(cur); }
        PG8_STAMP();
        if (!has_next) break;
#pragma unroll
        for (int a = 0; a < 2; ++a)
#pragma unroll
            for (int b = 0; b < 2; ++b)
#pragma unroll
                for (int m = 0; m < 4; ++m)
#pragma unroll
                    for (int n = 0; n < 2; ++n) acc[a][b][m][n] = (f32x4){0.f, 0.f, 0.f, 0.f};
        cur = nxt; cA = nA; cB = nB; ++ui;
    }
    PG8_WAIT_V(0);
    if (wr == 0) PG8_BAR;
    PG8_BAR;
    if constexpr (Epi::AFTER_DRAIN) { E.fused(acc, cur, wr, wc, fr, fq, lds, wid, lane); S.done(cur); }
    PG8_STAMP();
    if (STAMP && wid == 0) { stamps[lane] = lane < nts ? (((unsigned long long)(unsigned)ts_hi << 32) | (unsigned)ts_lo) : 0ull;
        if (lane == 62) stamps[62] = rt_entry; if (lane == 63) stamps[63] = (unsigned long long)wall_clock64(); }
#undef PG8_STAMP
#undef PG8_SA
#undef PG8_SB
#undef PG8_STAGE
#undef PG8_LDA
#undef PG8_LDB
#undef PG8_MMA
#undef PG8_WAIT_V
#undef PG8_WAIT_L
#undef PG8_BAR
#undef PG8_SCHED
}
}
namespace pg8 {
struct EpiStoreBf16 {
    static constexpr bool PERM = true, AFTER_DRAIN = false;
    bf16_t* O; int ldc;
    __device__ __forceinline__ void operator()(const f32x4 (&acc)[2][2][4][2], const Unit& u, int wr, int wc, int fr, int fq) const {
        const int row0 = u.pm * BM + wr * 64 + fr; const int col0 = u.pn * BM + wc * 32 + 8 * fq;
#pragma unroll
        for (int ai = 0; ai < 2; ++ai)
#pragma unroll
            for (int m = 0; m < 4; ++m) { bf16_t* rowp = O + (size_t)(row0 + ai * HALF + m * 16) * ldc + col0;
#pragma unroll
                for (int bj = 0; bj < 2; ++bj) { const f32x4 v0 = acc[ai][bj][m][0], v1 = acc[ai][bj][m][1];
                    u32x4 w; w.x = cvt_pk_bf16(v0[0], v0[1]); w.y = cvt_pk_bf16(v0[2], v0[3]); w.z = cvt_pk_bf16(v1[0], v1[1]); w.w = cvt_pk_bf16(v1[2], v1[3]);
                    *(u32x4*)(rowp + bj * HALF) = w; } }
    }
};
}

#define DI __device__ __forceinline__
typedef unsigned short u16;
typedef short bf16x8 __attribute__((ext_vector_type(8)));
typedef short s16x4 __attribute__((ext_vector_type(4)));
typedef float f32x4 __attribute__((ext_vector_type(4)));
typedef float f32x16 __attribute__((ext_vector_type(16)));
typedef unsigned u32x4 __attribute__((ext_vector_type(4)));
typedef unsigned u32x2 __attribute__((ext_vector_type(2)));

constexpr int NLAT = 32768, NCTX = 1024, NTOK = 33792, DM = 1024, NP = 2560, SEQ = 8192, CTXL = 256, SKV = 8448, NIN = 2400;
constexpr int C_CKV = 0, C_KR = 128, C_S5 = 160, C_CQ = 416, C_POOL = 608, C_SU = 864, C_SV = 1120, C_G = 1376;
constexpr float LN_EPS = 1e-6f, ALPHA = 1.4142135623730951f;
constexpr float QSCALE = 0.10206207261596575f * 1.4426950408889634f;
constexpr int KSPLIT = 8;

constexpr size_t OFF_WTIN = 0;
constexpr size_t OFF_WTOUT = OFF_WTIN + (size_t)2 * NP * DM * 2;
constexpr size_t OFF_WTUKV = OFF_WTOUT + (size_t)2 * DM * DM * 2;
constexpr size_t OFF_WTUQ = OFF_WTUKV + (size_t)2 * 512 * 128 * 2;
constexpr size_t OFF_WTGLU = OFF_WTUQ + (size_t)2 * 384 * 192 * 2;
constexpr size_t OFF_WTPOOL = OFF_WTGLU + (size_t)2 * 256 * 256 * 2;
constexpr size_t OFF_WS16 = OFF_WTPOOL + (size_t)2 * 4 * 64 * 64 * 2;
constexpr size_t OFF_MODP = OFF_WS16 + (size_t)2 * 4 * 128 * 128 * 2;
constexpr size_t OFF_LB = OFF_MODP + (size_t)2 * KSPLIT * 5 * 3072 * 4;
constexpr size_t OFF_BBR = OFF_LB + (size_t)4096 * 2 * 4;
constexpr size_t OFF_BBI = OFF_BBR + (size_t)4096 * 16 * 2;
constexpr size_t OFF_CM = OFF_BBI + (size_t)4096 * 16 * 2;
constexpr size_t OFF_ROPE = OFF_CM + (size_t)64 * 16 * 128 * 2;
constexpr size_t OFF_E = OFF_ROPE + (size_t)8192 * 16 * 2 * 4;
constexpr size_t OFF_CTX1 = OFF_E + (size_t)2 * 4 * 66 * 16 * 64 * 2 * 4;
constexpr size_t OFF_H = OFF_CTX1 + (size_t)NCTX * DM * 4;
constexpr size_t OFF_PROJ = OFF_H + (size_t)NTOK * DM * 2;
constexpr size_t OFF_Y = OFF_PROJ + (size_t)NTOK * NP * 2;
constexpr size_t OFF_Q = OFF_Y + (size_t)NTOK * DM * 2;
constexpr size_t OFF_K = OFF_Q + (size_t)16 * SKV * 96 * 2;
constexpr size_t OFF_V = OFF_K + (size_t)16 * SKV * 96 * 2;
constexpr size_t OFF_BAR = OFF_V + (size_t)16 * SKV * 64 * 2;
constexpr size_t OFF_CNT = OFF_BAR + 16384;
constexpr size_t BAR_BYTES = 16384 + 256;
constexpr size_t WS_END = OFF_CNT + 256;

constexpr int LDS_BYTES = 147456;

struct Params {
    const float *x, *c, *ctx, *c_ctx, *w_mod, *b_mod, *w_in, *g_q, *w_uq, *g_kv, *w_ukv, *w_pool, *pool_scale, *lam_re, *lam_im, *log_dt,
        *b_re, *b_im, *c_re, *c_im, *s5_d, *w_glu, *b_glu, *sgu_g, *sgu_b, *w_s, *b_s, *w_out, *ln_g, *ln_b;
    float* out; unsigned char* ws;
};

DI int otid() { int t = threadIdx.x; asm volatile("" : "+v"(t)); return t; }
typedef float f32x2_ __attribute__((ext_vector_type(2)));
typedef __bf16 bf16x2_ __attribute__((ext_vector_type(2)));
DI unsigned cvtpk(float lo, float hi) { const f32x2_ v = {lo, hi}; const bf16x2_ b = __builtin_convertvector(v, bf16x2_); return __builtin_bit_cast(unsigned, b); }
DI float bflo(unsigned w) { return __uint_as_float(w << 16); }
DI float bfhi(unsigned w) { return __uint_as_float(w & 0xffff0000u); }
DI float bf2f(u16 v) { return __uint_as_float(((unsigned)v) << 16); }
DI u16 f2bf(float x) { return (u16)(cvtpk(x, x) & 0xffffu); }
DI int crow(int r, int hi) { return (r & 3) + 8 * (r >> 2) + 4 * hi; }
template <int CTRL> DI float dpp_f(float v) { return __builtin_bit_cast(float, __builtin_amdgcn_update_dpp(0, __builtin_bit_cast(int, v), CTRL, 0xf, 0xf, true)); }
DI float wave_sum(float v) {
    v += dpp_f<0xB1>(v);
    v += dpp_f<0x4E>(v);
    v += dpp_f<0x141>(v);
    v += dpp_f<0x140>(v);
    const int iv = __builtin_bit_cast(int, v);
    const float a = __builtin_bit_cast(float, __builtin_amdgcn_readlane(iv, 0)), b = __builtin_bit_cast(float, __builtin_amdgcn_readlane(iv, 16));
    const float c = __builtin_bit_cast(float, __builtin_amdgcn_readlane(iv, 32)), d = __builtin_bit_cast(float, __builtin_amdgcn_readlane(iv, 48));
    return (a + b) + (c + d);
}
DI float fexp2(float x) { return __builtin_amdgcn_exp2f(x); }
DI float sigmoidf_(float x) { return __builtin_amdgcn_rcpf(1.f + fexp2(-1.4426950408889634f * x)); }
DI float siluf_(float x) { return x * sigmoidf_(x); }
DI float gelu_tanh(float y) { const float u = 0.7978845608028654f * (y + 0.044715f * y * y * y); return y * sigmoidf_(2.f * u); }
#define MFMA32(a, b, c) __builtin_amdgcn_mfma_f32_32x32x16_bf16((a), (b), (c), 0, 0, 0)
#define MFMA16(a, b, c) __builtin_amdgcn_mfma_f32_16x16x32_bf16((a), (b), (c), 0, 0, 0)

DI void sincos_acc(float x, float& s, float& c) {
    const float k = rintf(x * 0.6366197723675814f);
    float r = fmaf(k, -1.5707963705062866f, x);
    r = fmaf(k, 4.371138828673793e-8f, r);
    const int q = ((int)k) & 3;
    const float r2 = r * r;
    const float sp = fmaf(r * r2, fmaf(r2, fmaf(r2, -1.9515295891e-4f, 8.3321608736e-3f), -1.6666654611e-1f), r);
    const float cp = fmaf(r2 * r2, fmaf(r2, fmaf(r2, 2.443315711809948e-5f, -1.388731625493765e-3f), 4.166664568298827e-2f), fmaf(r2, -0.5f, 1.f));
    const float s0 = (q & 1) ? cp : sp, c0 = (q & 1) ? sp : cp;
    s = (q & 2) ? -s0 : s0;
    c = ((q == 1) || (q == 2)) ? -c0 : c0;
}

DI void transpose_tile(const float* __restrict__ src, int C, int r0, int c0, u16* __restrict__ dst, int ldd, float* tile) {
    const int tid = otid();
#pragma unroll
    for (int i = 0; i < 2; ++i) {
        const int r = (tid >> 4) + 32 * i, c = (tid & 15) * 4;
        f32x4 v = {0.f, 0.f, 0.f, 0.f};
        if (c0 + c < C) v = *(const f32x4*)(src + (size_t)(r0 + r) * C + c0 + c);
        tile[r * 65 + c] = v[0]; tile[r * 65 + c + 1] = v[1]; tile[r * 65 + c + 2] = v[2]; tile[r * 65 + c + 3] = v[3];
    }
    __syncthreads();
    const int c = tid >> 3, r8 = (tid & 7) * 8;
    if (c0 + c < C) {
        u32x4 w;
        w.x = cvtpk(tile[(r8 + 0) * 65 + c], tile[(r8 + 1) * 65 + c]); w.y = cvtpk(tile[(r8 + 2) * 65 + c], tile[(r8 + 3) * 65 + c]);
        w.z = cvtpk(tile[(r8 + 4) * 65 + c], tile[(r8 + 5) * 65 + c]); w.w = cvtpk(tile[(r8 + 6) * 65 + c], tile[(r8 + 7) * 65 + c]);
        *(u32x4*)(dst + (size_t)(c0 + c) * ldd + r0 + r8) = w;
    }
    __syncthreads();
}

DI void phase_w(const Params& p, unsigned char* smem) {
    float* tile = (float*)smem;
    const int tid = otid();
    u16* wtin = (u16*)(p.ws + OFF_WTIN); u16* wtout = (u16*)(p.ws + OFF_WTOUT); u16* wtukv = (u16*)(p.ws + OFF_WTUKV); u16* wtuq = (u16*)(p.ws + OFF_WTUQ);
    u16* wtglu = (u16*)(p.ws + OFF_WTGLU); u16* wtpool = (u16*)(p.ws + OFF_WTPOOL); u16* ws16 = (u16*)(p.ws + OFF_WS16);
    constexpr int T_IN = 16 * 38, T_OUT = 256, T_UKV = 16, T_UQ = 18, T_GLU = 16, T_POOL = 4, T_L = T_IN + T_OUT + T_UKV + T_UQ + T_GLU + T_POOL;
    constexpr int U_TR = 2 * T_L, U_PAD = 80, U_WS = 32, U_MOD = 2 * 6 * KSPLIT, U_S5 = 8, U_ROPE = 256;
    constexpr int U_TOT = U_TR + U_PAD + U_WS + U_MOD + U_S5 + U_ROPE;
    for (int u = blockIdx.x; u < U_TOT; u += gridDim.x) {
        int v = u;
        if (v < U_TR) {
            const int l = v / T_L; int t = v % T_L;
            if (t < T_IN) { transpose_tile(p.w_in + (size_t)l * DM * NIN, NIN, (t / 38) * 64, (t % 38) * 64, wtin + (size_t)l * NP * DM, DM, tile); continue; }
            t -= T_IN;
            if (t < T_OUT) { transpose_tile(p.w_out + (size_t)l * DM * DM, DM, (t / 16) * 64, (t % 16) * 64, wtout + (size_t)l * DM * DM, DM, tile); continue; }
            t -= T_OUT;
            if (t < T_UKV) { transpose_tile(p.w_ukv + (size_t)l * 128 * 512, 512, (t / 8) * 64, (t % 8) * 64, wtukv + (size_t)l * 512 * 128, 128, tile); continue; }
            t -= T_UKV;
            if (t < T_UQ) { transpose_tile(p.w_uq + (size_t)l * 192 * 384, 384, (t / 6) * 64, (t % 6) * 64, wtuq + (size_t)l * 384 * 192, 192, tile); continue; }
            t -= T_UQ;
            if (t < T_GLU) { transpose_tile(p.w_glu + (size_t)l * 256 * 256, 256, (t / 4) * 64, (t % 4) * 64, wtglu + (size_t)l * 256 * 256, 256, tile); continue; }
            t -= T_GLU;
            transpose_tile(p.w_pool + (size_t)(l * 4 + t) * 64 * 64, 64, 0, 0, wtpool + (size_t)(l * 4 + t) * 64 * 64, 64, tile);
            continue;
        }
        v -= U_TR;
        if (v < U_PAD) {
            const int e = (v * 512 + tid) * 8; const int l = e / (160 * 1024), o = e % (160 * 1024);
            *(u32x4*)(wtin + (size_t)l * NP * DM + (size_t)NIN * DM + o) = (u32x4){0u, 0u, 0u, 0u};
            continue;
        }
        v -= U_PAD;
        if (v < U_WS) {
            const int e = (v * 512 + tid) * 8;
            const f32x4 a = *(const f32x4*)(p.w_s + e), b = *(const f32x4*)(p.w_s + e + 4);
            u32x4 w; w.x = cvtpk(a[0], a[1]); w.y = cvtpk(a[2], a[3]); w.z = cvtpk(b[0], b[1]); w.w = cvtpk(b[2], b[3]);
            *(u32x4*)(ws16 + e) = w;
            continue;
        }
        v -= U_WS;
        if (v < U_MOD) {
            const int l = v / (6 * KSPLIT), chunk = (v / KSPLIT) % 6, ks = v % KSPLIT;
            constexpr int KL = DM / KSPLIT;
            float* sv = (float*)smem;
            for (int i = tid; i < 5 * KL; i += 512) { const int j = i / KL, kk = i % KL; const float a = (j < 4) ? p.c[j * DM + ks * KL + kk] : p.c_ctx[ks * KL + kk]; sv[i] = siluf_(a); }
            __syncthreads();
            const int n = chunk * 512 + tid;
            const float* wp = p.w_mod + (size_t)l * DM * 3072 + (size_t)(ks * KL) * 3072 + n;
            float a0 = 0.f, a1 = 0.f, a2 = 0.f, a3 = 0.f, a4 = 0.f;
#pragma unroll 8
            for (int kk = 0; kk < KL; ++kk) { const float w = wp[(size_t)kk * 3072]; a0 = fmaf(sv[kk], w, a0); a1 = fmaf(sv[KL + kk], w, a1); a2 = fmaf(sv[2 * KL + kk], w, a2); a3 = fmaf(sv[3 * KL + kk], w, a3); a4 = fmaf(sv[4 * KL + kk], w, a4); }
            float* mp = (float*)(p.ws + OFF_MODP) + (size_t)((l * KSPLIT + ks) * 5) * 3072 + n;
            mp[0] = a0; mp[3072] = a1; mp[2 * 3072] = a2; mp[3 * 3072] = a3; mp[4 * 3072] = a4;
            __syncthreads();
            continue;
        }
        v -= U_MOD;
        if (v < U_S5) {
            const int idx = v * 512 + tid;
            const float lr = p.lam_re[idx], li = p.lam_im[idx], dt = expf(p.log_dt[idx >> 6]);
            const float mag = expf(lr * dt); float sn, cs; sincos_acc(li * dt, sn, cs);
            const float lbr = mag * cs, lbi = mag * sn, nr = lbr - 1.f, ni = lbi, den = lr * lr + li * li;
            const float kr = (nr * lr + ni * li) / den, ki = (ni * lr - nr * li) / den;
            float* lb = (float*)(p.ws + OFF_LB); lb[idx * 2] = lbr; lb[idx * 2 + 1] = lbi;
            u16* bbr = (u16*)(p.ws + OFF_BBR) + (size_t)idx * 16; u16* bbi = (u16*)(p.ws + OFF_BBI) + (size_t)idx * 16;
            u16* cm = (u16*)(p.ws + OFF_CM);
            const int pp = idx & 63;
            for (int h = 0; h < 16; ++h) {
                const float br = p.b_re[(size_t)idx * 16 + h], bi = p.b_im[(size_t)idx * 16 + h];
                bbr[h] = f2bf(kr * br - ki * bi); bbi[h] = f2bf(kr * bi + ki * br);
                const size_t ci = ((size_t)(idx >> 6) * 16 + h) * 64 + pp;
                *(unsigned*)(cm + ((size_t)(idx >> 6) * 16 + h) * 128 + 2 * pp) = cvtpk(p.c_re[ci], -p.c_im[ci]);
            }
            continue;
        }
        v -= U_S5;
        {
            const int it = v * 512 + tid; const int t = it >> 4, a = (it >> 3) & 1, f = it & 7;
            const float pos = (float)(a ? (t & 63) : (t >> 6));
            const float inv = exp2f(-(float)f * 0.125f * 13.287712379549449f);
            float sn, cs; sincos_acc(pos * inv, sn, cs);
            float* rp = (float*)(p.ws + OFF_ROPE) + (size_t)it * 2; rp[0] = cs; rp[1] = sn;
        }
    }
}

DI void load_mod(const Params& p, int l, int j, int which, float* dst) {
    const float* mp = (const float*)(p.ws + OFF_MODP);
    for (int c = otid(); c < DM; c += 512) {
        float v = p.b_mod[l * 3072 + which * DM + c];
#pragma unroll
        for (int ks = 0; ks < KSPLIT; ++ks) v += mp[(size_t)((l * KSPLIT + ks) * 5 + j) * 3072 + which * DM + c];
        dst[c] = v;
    }
}

DI void phase_a(const Params& p, unsigned char* smem) {
    float* shift = (float*)smem; float* scale = shift + DM;
    u16* hb = (u16*)(p.ws + OFF_H);
    const int tid = otid(), wid = __builtin_amdgcn_readfirstlane(tid >> 6), lane = tid & 63;
    for (int u = blockIdx.x; u < 512; u += gridDim.x) {
        const bool cx = u >= 256; const int r0 = cx ? NLAT + (u - 256) * 4 : u * 128; const int j = cx ? 4 : (r0 >> 13);
        const int rpw = cx ? 1 : 16;
        __syncthreads();
        load_mod(p, 0, j, 0, shift); load_mod(p, 0, j, 1, scale);
        __syncthreads();
        if (cx && wid >= 4) continue;
        const int rowb = r0 + wid * rpw;
        const float* xb_ = (rowb < NLAT) ? p.x + (size_t)rowb * DM : p.ctx + (size_t)(rowb - NLAT) * DM;
        f32x4 nx[4];
#pragma unroll
        for (int i = 0; i < 4; ++i) nx[i] = __builtin_nontemporal_load((const f32x4*)(xb_ + i * 256 + lane * 4));
        f32x4 sc4[4], sh4[4];
#pragma unroll
        for (int i = 0; i < 4; ++i) { sc4[i] = *(const f32x4*)(scale + i * 256 + lane * 4); sh4[i] = *(const f32x4*)(shift + i * 256 + lane * 4); }
        for (int rr = 0; rr < rpw; ++rr) {
            const int row = rowb + rr;
            f32x4 v[4]; float s = 0.f;
#pragma unroll
            for (int i = 0; i < 4; ++i) { v[i] = nx[i]; s += v[i][0] + v[i][1] + v[i][2] + v[i][3]; }
            if (rr + 1 < rpw) {
#pragma unroll
                for (int i = 0; i < 4; ++i) nx[i] = __builtin_nontemporal_load((const f32x4*)(xb_ + (size_t)(rr + 1) * DM + i * 256 + lane * 4));
            }
            const float mean = wave_sum(s) * (1.f / DM);
            float q = 0.f;
#pragma unroll
            for (int i = 0; i < 4; ++i)
#pragma unroll
                for (int k = 0; k < 4; ++k) { const float d = v[i][k] - mean; q += d * d; }
            const float rstd = rsqrtf(wave_sum(q) * (1.f / DM) + LN_EPS);
#pragma unroll
            for (int i = 0; i < 4; ++i) {
                const int c = i * 256 + lane * 4; float o[4];
#pragma unroll
                for (int k = 0; k < 4; ++k) o[k] = (v[i][k] - mean) * rstd * (1.f + sc4[i][k]) + sh4[i][k];
                u32x2 w; w.x = cvtpk(o[0], o[1]); w.y = cvtpk(o[2], o[3]);
                *(u32x2*)(hb + (size_t)row * DM + c) = w;
            }
        }
    }
}

#ifndef S5_OUT_SCALE
#define S5_OUT_SCALE 1.f
#endif
#ifndef SGU_OUT_SCALE
#define SGU_OUT_SCALE 1.f
#endif
#ifndef POOL_OUT_SCALE
#define POOL_OUT_SCALE 1.f
#endif
#ifndef Y_SCALE
#define Y_SCALE 1.f
#endif
DI void phase_f(const Params& p, int l, unsigned char* smem) {
    float* gate = (float*)smem; float* shift = gate + DM; float* scale = shift + DM;
    const u16* yb = (const u16*)(p.ws + OFF_Y);
    u16* hb = (u16*)(p.ws + OFF_H);
    float* ctx1 = (float*)(p.ws + OFF_CTX1);
    const int tid = otid(), wid = __builtin_amdgcn_readfirstlane(tid >> 6), lane = tid & 63;
    const float* lg = p.ln_g + l * DM; const float* lbv = p.ln_b + l * DM;
    for (int u = blockIdx.x; u < (l ? 256 : 512); u += gridDim.x) {
        const bool cx = u >= 256; const int r0 = cx ? NLAT + (u - 256) * 4 : u * 128; const int j = cx ? 4 : (r0 >> 13);
        const int rpw = cx ? 1 : 16;
        __syncthreads();
        load_mod(p, l, j, 2, gate);
        if (l == 0) { load_mod(p, 1, j, 0, shift); load_mod(p, 1, j, 1, scale); }
        __syncthreads();
        if (cx && wid >= 4) continue;
        const int rowb = r0 + wid * rpw;
        const float* xb_; float* ob_;
        if (l == 0) { xb_ = (rowb < NLAT) ? p.x + (size_t)rowb * DM : p.ctx + (size_t)(rowb - NLAT) * DM; ob_ = (rowb < NLAT) ? p.out + (size_t)rowb * DM : ctx1 + (size_t)(rowb - NLAT) * DM; }
        else { xb_ = p.out + (size_t)rowb * DM; ob_ = p.out + (size_t)rowb * DM; }
        f32x4 nx[4]; u32x2 ny[4];
#pragma unroll
        for (int i = 0; i < 4; ++i) { nx[i] = __builtin_nontemporal_load((const f32x4*)(xb_ + i * 256 + lane * 4)); ny[i] = *(const u32x2*)(yb + (size_t)rowb * DM + i * 256 + lane * 4); }
        f32x4 gt4[4], g4r[4], b4r[4], sc4[4], sh4[4];
#pragma unroll
        for (int i = 0; i < 4; ++i) {
            const int c = i * 256 + lane * 4;
            gt4[i] = *(const f32x4*)(gate + c); g4r[i] = *(const f32x4*)(lg + c); b4r[i] = *(const f32x4*)(lbv + c);
            if (l == 0) { sc4[i] = *(const f32x4*)(scale + c); sh4[i] = *(const f32x4*)(shift + c); }
        }
        for (int rr = 0; rr < rpw; ++rr) {
            const int row = rowb + rr;
            float* op = ob_ + (size_t)rr * DM;
            f32x4 v[4]; float s = 0.f;
            f32x4 cx[4]; u32x2 cy[4];
#pragma unroll
            for (int i = 0; i < 4; ++i) { cx[i] = nx[i]; cy[i] = ny[i]; }
            if (rr + 1 < rpw) {
#pragma unroll
                for (int i = 0; i < 4; ++i) { nx[i] = __builtin_nontemporal_load((const f32x4*)(xb_ + (size_t)(rr + 1) * DM + i * 256 + lane * 4)); ny[i] = *(const u32x2*)(yb + (size_t)(row + 1) * DM + i * 256 + lane * 4); }
            }
#pragma unroll
            for (int i = 0; i < 4; ++i) {
                const int c = i * 256 + lane * 4;
                const f32x4 xv = cx[i]; const u32x2 yw = cy[i];
                v[i][0] = ALPHA * xv[0] + Y_SCALE * gt4[i][0] * bflo(yw.x); v[i][1] = ALPHA * xv[1] + Y_SCALE * gt4[i][1] * bfhi(yw.x);
                v[i][2] = ALPHA * xv[2] + Y_SCALE * gt4[i][2] * bflo(yw.y); v[i][3] = ALPHA * xv[3] + Y_SCALE * gt4[i][3] * bfhi(yw.y);
                s += v[i][0] + v[i][1] + v[i][2] + v[i][3];
            }
            const float mean = wave_sum(s) * (1.f / DM);
            float q = 0.f;
#pragma unroll
            for (int i = 0; i < 4; ++i)
#pragma unroll
                for (int k = 0; k < 4; ++k) { const float d = v[i][k] - mean; q += d * d; }
            const float rstd = rsqrtf(wave_sum(q) * (1.f / DM) + LN_EPS);
            float s2 = 0.f;
#pragma unroll
            for (int i = 0; i < 4; ++i) {
                const int c = i * 256 + lane * 4;
#pragma unroll
                for (int k = 0; k < 4; ++k) { v[i][k] = (v[i][k] - mean) * rstd * g4r[i][k] + b4r[i][k]; s2 += v[i][k]; }
                __builtin_nontemporal_store(v[i], (f32x4*)(op + c));
            }
            if (l == 0) {
                const float m2 = wave_sum(s2) * (1.f / DM);
                float q2 = 0.f;
#pragma unroll
                for (int i = 0; i < 4; ++i)
#pragma unroll
                    for (int k = 0; k < 4; ++k) { const float d = v[i][k] - m2; q2 += d * d; }
                const float rs2 = rsqrtf(wave_sum(q2) * (1.f / DM) + LN_EPS);
#pragma unroll
                for (int i = 0; i < 4; ++i) {
                    const int c = i * 256 + lane * 4; float o[4];
#pragma unroll
                    for (int k = 0; k < 4; ++k) o[k] = (v[i][k] - m2) * rs2 * (1.f + sc4[i][k]) + sh4[i][k];
                    u32x2 w; w.x = cvtpk(o[0], o[1]); w.y = cvtpk(o[2], o[3]);
                    *(u32x2*)(hb + (size_t)row * DM + c) = w;
                }
            }
        }
    }
}

DI void phase_gemm(const u16* A, const u16* Bt, u16* O, int M, int N, int ldc, unsigned char* smem) {
    pg8::Gemm g; g.A = A; g.Bt = Bt; g.M = M; g.N = N; g.K = DM;
    pg8::StaticOrder S; S.init(M, N, (int)gridDim.x, (int)blockIdx.x);
    pg8::EpiStoreBf16 E; E.O = O; E.ldc = ldc;
    pg8::gemm_phase<pg8::EpiStoreBf16, pg8::StaticOrder, false>((PG8_LAS unsigned char*)smem, g, S, E, nullptr);
}

struct OneUnitOrder {
    int pm, pn;
    __device__ __forceinline__ bool next(int i, pg8::Unit& u) const { if (i != 0) return false; u.pm = pm; u.pn = pn; return true; }
    __device__ __forceinline__ void a_ready(const pg8::Unit&) const {}
    __device__ __forceinline__ void done(const pg8::Unit&) const {}
};
DI void unit_gemm_one(const u16* A, const u16* Bt, u16* O, int N, int pm, int pn, unsigned char* smem) {
    pg8::Gemm g; g.A = A; g.Bt = Bt; g.M = NTOK; g.N = N; g.K = DM;
    OneUnitOrder S; S.pm = pm; S.pn = pn;
    pg8::EpiStoreBf16 E; E.O = O; E.ldc = N;
    __syncthreads();
    pg8::gemm_phase<pg8::EpiStoreBf16, OneUnitOrder, false>((PG8_LAS unsigned char*)smem, g, S, E, nullptr);
}
DI void publish_unit(unsigned* cnt) {
    asm volatile("s_waitcnt vmcnt(0)" ::: "memory");
    __syncthreads();
    if (threadIdx.x == 0) { __threadfence(); __hip_atomic_fetch_add(cnt, 1u, __ATOMIC_RELEASE, __HIP_MEMORY_SCOPE_AGENT); }
}
DI void wait_units(const unsigned* cnt, unsigned need) {
    if (threadIdx.x == 0) { while (__hip_atomic_load(cnt, __ATOMIC_RELAXED, __HIP_MEMORY_SCOPE_AGENT) < need) __builtin_amdgcn_s_sleep(8); }
    __syncthreads();
    asm volatile("buffer_inv sc1\n\ts_waitcnt vmcnt(0)" ::: "memory");
}
DI void unit_gemm_ctx(const Params& p, int l, int i, unsigned char* smem, unsigned* done_cnt) {
    const int npn = l ? 2 : 10;
    pg8::Gemm g; g.A = (const u16*)(p.ws + OFF_H); g.Bt = (const u16*)(p.ws + OFF_WTIN) + (size_t)l * NP * DM; g.M = NTOK; g.N = NP; g.K = DM;
    OneUnitOrder S; S.pm = 128 + i / npn; S.pn = i % npn;
    pg8::EpiStoreBf16 E; E.O = (u16*)(p.ws + OFF_PROJ); E.ldc = NP;
    __syncthreads();
    pg8::gemm_phase<pg8::EpiStoreBf16, OneUnitOrder, false>((PG8_LAS unsigned char*)smem, g, S, E, nullptr);
    asm volatile("s_waitcnt vmcnt(0)" ::: "memory");
    __syncthreads();
    if (threadIdx.x == 0) { __threadfence(); __hip_atomic_fetch_add(done_cnt, 1u, __ATOMIC_RELEASE, __HIP_MEMORY_SCOPE_AGENT); }
}

DI void row_info(int r, int& b, int& t, int& isctx) { if (r < NLAT) { b = r >> 13; t = r & 8191; isctx = 0; } else { const int rc = r - NLAT; b = rc >> 8; t = rc & 255; isctx = 1; } }

DI void unit_mla(const Params& p, int l, int u, unsigned char* smem) {
    const int tid = otid(), wid = __builtin_amdgcn_readfirstlane(tid >> 6), lane = tid & 63, r32 = lane & 31, hi = lane >> 5;
    const u16* proj = (const u16*)(p.ws + OFF_PROJ);
    u16* Qg = (u16*)(p.ws + OFF_Q); u16* Kg = (u16*)(p.ws + OFF_K); u16* Vg = (u16*)(p.ws + OFF_V);
    const float* rope = (const float*)(p.ws + OFF_ROPE);
    u16* Akv = (u16*)smem;
    u16* Aq = (u16*)(smem + 64 * 272);
    const int r0 = u * 64; int b, t0, isctx; row_info(r0, b, t0, isctx);
    const int s0 = isctx ? t0 : 256 + t0;
    __syncthreads();
    {
        const int m = tid >> 3, q = tid & 7; const u16* pr = proj + (size_t)(r0 + m) * NP;
        u32x4 kv[2], cq[3], krv = {0u, 0u, 0u, 0u};
#pragma unroll
        for (int i = 0; i < 2; ++i) kv[i] = *(const u32x4*)(pr + C_CKV + q * 16 + i * 8);
#pragma unroll
        for (int i = 0; i < 3; ++i) cq[i] = *(const u32x4*)(pr + C_CQ + q * 24 + i * 8);
        if (q < 4) krv = *(const u32x4*)(pr + C_KR + q * 8);
        f32x4 gk[4], gq[6];
#pragma unroll
        for (int i = 0; i < 4; ++i) gk[i] = *(const f32x4*)(p.g_kv + l * 128 + q * 16 + i * 4);
#pragma unroll
        for (int i = 0; i < 6; ++i) gq[i] = *(const f32x4*)(p.g_q + l * 192 + q * 24 + i * 4);
        float cs[8], sn[8];
        if (q < 4 && !isctx) {
            const float* rp = rope + ((size_t)(t0 + m) * 16 + (q >> 1) * 8) * 2;
#pragma unroll
            for (int i = 0; i < 4; ++i) { const f32x4 v = *(const f32x4*)(rp + i * 4); cs[2 * i] = v[0]; sn[2 * i] = v[1]; cs[2 * i + 1] = v[2]; sn[2 * i + 1] = v[3]; }
        } else {
#pragma unroll
            for (int i = 0; i < 8; ++i) { cs[i] = 1.f; sn[i] = 0.f; }
        }
        { float x[16]; float ss = 0.f;
#pragma unroll
          for (int i = 0; i < 2; ++i) { x[8 * i] = bflo(kv[i].x); x[8 * i + 1] = bfhi(kv[i].x); x[8 * i + 2] = bflo(kv[i].y); x[8 * i + 3] = bfhi(kv[i].y);
              x[8 * i + 4] = bflo(kv[i].z); x[8 * i + 5] = bfhi(kv[i].z); x[8 * i + 6] = bflo(kv[i].w); x[8 * i + 7] = bfhi(kv[i].w); }
#pragma unroll
          for (int i = 0; i < 16; ++i) ss += x[i] * x[i];
          ss += dpp_f<0xB1>(ss); ss += dpp_f<0x4E>(ss); ss += dpp_f<0x141>(ss);
          const float rs = rsqrtf(ss * (1.f / 128.f) + LN_EPS);
#pragma unroll
          for (int i = 0; i < 2; ++i) { u32x4 w;
              w.x = cvtpk(x[8 * i] * rs * gk[2 * i][0], x[8 * i + 1] * rs * gk[2 * i][1]); w.y = cvtpk(x[8 * i + 2] * rs * gk[2 * i][2], x[8 * i + 3] * rs * gk[2 * i][3]);
              w.z = cvtpk(x[8 * i + 4] * rs * gk[2 * i + 1][0], x[8 * i + 5] * rs * gk[2 * i + 1][1]); w.w = cvtpk(x[8 * i + 6] * rs * gk[2 * i + 1][2], x[8 * i + 7] * rs * gk[2 * i + 1][3]);
              *(u32x4*)(Akv + m * 136 + q * 16 + i * 8) = w; } }
        { float x[24]; float ss = 0.f;
#pragma unroll
          for (int i = 0; i < 3; ++i) { x[8 * i] = bflo(cq[i].x); x[8 * i + 1] = bfhi(cq[i].x); x[8 * i + 2] = bflo(cq[i].y); x[8 * i + 3] = bfhi(cq[i].y);
              x[8 * i + 4] = bflo(cq[i].z); x[8 * i + 5] = bfhi(cq[i].z); x[8 * i + 6] = bflo(cq[i].w); x[8 * i + 7] = bfhi(cq[i].w); }
#pragma unroll
          for (int i = 0; i < 24; ++i) ss += x[i] * x[i];
          ss += dpp_f<0xB1>(ss); ss += dpp_f<0x4E>(ss); ss += dpp_f<0x141>(ss);
          const float rs = rsqrtf(ss * (1.f / 192.f) + LN_EPS);
#pragma unroll
          for (int i = 0; i < 3; ++i) { u32x4 w;
              w.x = cvtpk(x[8 * i] * rs * gq[2 * i][0], x[8 * i + 1] * rs * gq[2 * i][1]); w.y = cvtpk(x[8 * i + 2] * rs * gq[2 * i][2], x[8 * i + 3] * rs * gq[2 * i][3]);
              w.z = cvtpk(x[8 * i + 4] * rs * gq[2 * i + 1][0], x[8 * i + 5] * rs * gq[2 * i + 1][1]); w.w = cvtpk(x[8 * i + 6] * rs * gq[2 * i + 1][2], x[8 * i + 7] * rs * gq[2 * i + 1][3]);
              *(u32x4*)(Aq + m * 200 + q * 24 + i * 8) = w; } }
        { u32x4 pw;
          pw.x = (unsigned)__builtin_amdgcn_update_dpp(0, (int)krv.x, 0xB1, 0xf, 0xf, true); pw.y = (unsigned)__builtin_amdgcn_update_dpp(0, (int)krv.y, 0xB1, 0xf, 0xf, true);
          pw.z = (unsigned)__builtin_amdgcn_update_dpp(0, (int)krv.z, 0xB1, 0xf, 0xf, true); pw.w = (unsigned)__builtin_amdgcn_update_dpp(0, (int)krv.w, 0xB1, 0xf, 0xf, true);
          if (q < 4) {
              const float sg = (q & 1) ? 1.f : -1.f;
              float me[8], ot[8];
              me[0] = bflo(krv.x); me[1] = bfhi(krv.x); me[2] = bflo(krv.y); me[3] = bfhi(krv.y); me[4] = bflo(krv.z); me[5] = bfhi(krv.z); me[6] = bflo(krv.w); me[7] = bfhi(krv.w);
              ot[0] = bflo(pw.x); ot[1] = bfhi(pw.x); ot[2] = bflo(pw.y); ot[3] = bfhi(pw.y); ot[4] = bflo(pw.z); ot[5] = bfhi(pw.z); ot[6] = bflo(pw.w); ot[7] = bfhi(pw.w);
              float o[8];
#pragma unroll
              for (int i = 0; i < 8; ++i) o[i] = me[i] * cs[i] + sg * ot[i] * sn[i];
              u32x4 w; w.x = cvtpk(o[0], o[1]); w.y = cvtpk(o[2], o[3]); w.z = cvtpk(o[4], o[5]); w.w = cvtpk(o[6], o[7]);
#pragma unroll
              for (int h = 0; h < 4; ++h) *(u32x4*)(Kg + ((size_t)(b * 4 + h) * SKV + s0 + m) * 96 + 64 + q * 8) = w;
          } }
    }
    __syncthreads();
    {
        const int h = wid >> 1, part = wid & 1, n0 = h * 128 + part * 64;
        const u16* W = (const u16*)(p.ws + OFF_WTUKV) + (size_t)l * 512 * 128;
        f32x16 acc[2][2];
#pragma unroll
        for (int i = 0; i < 2; ++i)
#pragma unroll
            for (int j = 0; j < 2; ++j)
#pragma unroll
                for (int r = 0; r < 16; ++r) acc[i][j][r] = 0.f;
#pragma unroll
        for (int ks = 0; ks < 8; ++ks) {
            bf16x8 af[2], bf[2];
#pragma unroll
            for (int i = 0; i < 2; ++i) af[i] = *(const bf16x8*)(Akv + (i * 32 + r32) * 136 + ks * 16 + hi * 8);
#pragma unroll
            for (int j = 0; j < 2; ++j) bf[j] = *(const bf16x8*)(W + (size_t)(n0 + j * 32 + r32) * 128 + ks * 16 + hi * 8);
#pragma unroll
            for (int i = 0; i < 2; ++i)
#pragma unroll
                for (int j = 0; j < 2; ++j) acc[i][j] = MFMA32(bf[j], af[i], acc[i][j]);
        }
        u16* dst = part ? Vg : Kg; const int ld = part ? 64 : 96;
#pragma unroll
        for (int i = 0; i < 2; ++i)
#pragma unroll
            for (int j = 0; j < 2; ++j)
#pragma unroll
                for (int r4 = 0; r4 < 4; ++r4) {
                    u32x2 w; w.x = cvtpk(acc[i][j][4 * r4], acc[i][j][4 * r4 + 1]); w.y = cvtpk(acc[i][j][4 * r4 + 2], acc[i][j][4 * r4 + 3]);
                    *(u32x2*)(dst + ((size_t)(b * 4 + h) * SKV + s0 + i * 32 + r32) * ld + j * 32 + 8 * r4 + 4 * hi) = w;
                }
    }
    for (int blk = wid; blk < 12; blk += 8) {
        const int h = blk / 3, part = blk % 3, n0 = blk * 32;
        const u16* W = (const u16*)(p.ws + OFF_WTUQ) + (size_t)l * 384 * 192;
        f32x16 acc[2];
#pragma unroll
        for (int i = 0; i < 2; ++i)
#pragma unroll
            for (int r = 0; r < 16; ++r) acc[i][r] = 0.f;
#pragma unroll
        for (int ks = 0; ks < 12; ++ks) {
            const bf16x8 bfr = *(const bf16x8*)(W + (size_t)(n0 + r32) * 192 + ks * 16 + hi * 8);
#pragma unroll
            for (int i = 0; i < 2; ++i) { const bf16x8 af = *(const bf16x8*)(Aq + (i * 32 + r32) * 200 + ks * 16 + hi * 8); acc[i] = MFMA32(bfr, af, acc[i]); }
        }
#pragma unroll
        for (int i = 0; i < 2; ++i) {
            const int m = i * 32 + r32;
            if (part == 2 && !isctx) {
                const float* rp = rope + ((size_t)(t0 + m) * 16 + 4 * hi) * 2;
#pragma unroll
                for (int a = 0; a < 2; ++a) {
                    const f32x4 cs0 = *(const f32x4*)(rp + a * 16), cs1 = *(const f32x4*)(rp + a * 16 + 4);
                    const float cc[4] = {cs0[0], cs0[2], cs1[0], cs1[2]}, ss[4] = {cs0[1], cs0[3], cs1[1], cs1[3]};
#pragma unroll
                    for (int k = 0; k < 4; ++k) { const float x1 = acc[i][8 * a + k], x2 = acc[i][8 * a + 4 + k];
                        acc[i][8 * a + k] = x1 * cc[k] - x2 * ss[k]; acc[i][8 * a + 4 + k] = x2 * cc[k] + x1 * ss[k]; }
                }
            }
#pragma unroll
            for (int r4 = 0; r4 < 4; ++r4) {
                u32x2 w; w.x = cvtpk(acc[i][4 * r4] * QSCALE, acc[i][4 * r4 + 1] * QSCALE); w.y = cvtpk(acc[i][4 * r4 + 2] * QSCALE, acc[i][4 * r4 + 3] * QSCALE);
                *(u32x2*)(Qg + ((size_t)(b * 4 + h) * SKV + s0 + m) * 96 + part * 32 + 8 * r4 + 4 * hi) = w;
            }
        }
    }
}

DI void unit_sgu(const Params& p, int l, int u, unsigned char* smem) {
    const int tid = otid(), wid = __builtin_amdgcn_readfirstlane(tid >> 6), lane = tid & 63, r32 = lane & 31, hi = lane >> 5;
    const u16* proj = (const u16*)(p.ws + OFF_PROJ); u16* mix = (u16*)(p.ws + OFF_H);
    u16* vnT = (u16*)smem;
    const int r0 = u * 128;
    __syncthreads();
    {
        const int s = tid >> 2, q = tid & 3; const u16* pr = proj + (size_t)(r0 + s) * NP + C_SV + q * 64;
        float xv[64]; float sum = 0.f;
#pragma unroll
        for (int i = 0; i < 8; ++i) { const u32x4 w = *(const u32x4*)(pr + i * 8);
            xv[i * 8 + 0] = bflo(w.x); xv[i * 8 + 1] = bfhi(w.x); xv[i * 8 + 2] = bflo(w.y); xv[i * 8 + 3] = bfhi(w.y);
            xv[i * 8 + 4] = bflo(w.z); xv[i * 8 + 5] = bfhi(w.z); xv[i * 8 + 6] = bflo(w.w); xv[i * 8 + 7] = bfhi(w.w); }
#pragma unroll
        for (int i = 0; i < 64; ++i) sum += xv[i];
        sum += __shfl_xor(sum, 1); sum += __shfl_xor(sum, 2);
        const float mean = sum * (1.f / 256.f);
        float qq = 0.f;
#pragma unroll
        for (int i = 0; i < 64; ++i) { const float d = xv[i] - mean; qq += d * d; }
        qq += __shfl_xor(qq, 1); qq += __shfl_xor(qq, 2);
        const float rstd = rsqrtf(qq * (1.f / 256.f) + LN_EPS);
        const float* gg = p.sgu_g + l * 256 + q * 64; const float* bb = p.sgu_b + l * 256 + q * 64;
#pragma unroll
        for (int i = 0; i < 64; ++i) vnT[(q * 64 + i) * 136 + s] = f2bf((xv[i] - mean) * rstd * gg[i] + bb[i]);
    }
    __syncthreads();
    {
        const int h = wid >> 1, c0 = h * 64 + (wid & 1) * 32;
        const u16* W = (const u16*)(p.ws + OFF_WS16) + (size_t)(l * 4 + h) * 128 * 128;
        f32x16 acc[4];
#pragma unroll
        for (int i = 0; i < 4; ++i)
#pragma unroll
            for (int r = 0; r < 16; ++r) acc[i][r] = 0.f;
        bf16x8 afr[4][8];
#pragma unroll
        for (int i = 0; i < 4; ++i)
#pragma unroll
            for (int ks = 0; ks < 8; ++ks) afr[i][ks] = *(const bf16x8*)(W + (size_t)(i * 32 + r32) * 128 + ks * 16 + hi * 8);
#pragma unroll
        for (int ks = 0; ks < 8; ++ks) {
            const bf16x8 bfr = *(const bf16x8*)(vnT + (c0 + r32) * 136 + ks * 16 + hi * 8);
#pragma unroll
            for (int i = 0; i < 4; ++i) acc[i] = MFMA32(bfr, afr[i][ks], acc[i]);
        }
#pragma unroll
        for (int i = 0; i < 4; ++i) {
            const int t = i * 32 + r32; const size_t row = (size_t)(r0 + t);
            const float bs = p.b_s[(l * 4 + h) * 128 + t];
#pragma unroll
            for (int r4 = 0; r4 < 4; ++r4) {
                const int c = c0 + 8 * r4 + 4 * hi;
                const u32x2 uw = *(const u32x2*)(proj + row * NP + C_SU + c), gw = *(const u32x2*)(proj + row * NP + C_G + 768 + c);
                const float o0 = bflo(uw.x) * (acc[i][4 * r4] + bs) * siluf_(bflo(gw.x)), o1 = bfhi(uw.x) * (acc[i][4 * r4 + 1] + bs) * siluf_(bfhi(gw.x));
                const float o2 = bflo(uw.y) * (acc[i][4 * r4 + 2] + bs) * siluf_(bflo(gw.y)), o3 = bfhi(uw.y) * (acc[i][4 * r4 + 3] + bs) * siluf_(bfhi(gw.y));
                u32x2 w; w.x = cvtpk(SGU_OUT_SCALE * o0, SGU_OUT_SCALE * o1); w.y = cvtpk(SGU_OUT_SCALE * o2, SGU_OUT_SCALE * o3);
                *(u32x2*)(mix + row * DM + 768 + c) = w;
            }
        }
    }
}

DI void unit_pool(const Params& p, int l, int u, unsigned char* smem) {
    const int tid = otid(), wid = __builtin_amdgcn_readfirstlane(tid >> 6), lane = tid & 63, r32 = lane & 31, hi = lane >> 5;
    const u16* proj = (const u16*)(p.ws + OFF_PROJ); u16* mix = (u16*)(p.ws + OFF_H);
    u16* halo = (u16*)smem;
    u16* At = (u16*)(smem + 80 * 512);
    const int r0 = u * 64; int b, t0, isctx; row_info(r0, b, t0, isctx);
    const int n = isctx ? CTXL : SEQ; const int rbase = r0 - t0;
    __syncthreads();
    for (int i = tid; i < 80 * 32; i += 512) {
        const int hr = i >> 5, ch = i & 31; const int t = t0 - 8 + hr;
        if (t >= 0 && t < n) *(u32x4*)(halo + hr * 256 + ch * 8) = *(const u32x4*)(proj + (size_t)(rbase + t) * NP + C_POOL + ch * 8);
    }
    __syncthreads();
    for (int it = tid; it < 64 * 32; it += 512) {
        const int m = it >> 5, cg = it & 31, gi = cg >> 3, w = 2 << gi; const int t = t0 + m;
        const int lo = max(t - (w >> 1), 0), hiw = min(t + w - (w >> 1), n);
        float s[8];
#pragma unroll
        for (int k = 0; k < 8; ++k) s[k] = 0.f;
        for (int tt = lo; tt < hiw; ++tt) {
            const u32x4 v = *(const u32x4*)(halo + (tt - t0 + 8) * 256 + cg * 8);
            s[0] += bflo(v.x); s[1] += bfhi(v.x); s[2] += bflo(v.y); s[3] += bfhi(v.y); s[4] += bflo(v.z); s[5] += bfhi(v.z); s[6] += bflo(v.w); s[7] += bfhi(v.w);
        }
        const float inv = 1.f / (float)(hiw - lo);
        const u32x4 c = *(const u32x4*)(halo + (m + 8) * 256 + cg * 8);
        u32x4 o;
        o.x = cvtpk(s[0] * inv - bflo(c.x), s[1] * inv - bfhi(c.x)); o.y = cvtpk(s[2] * inv - bflo(c.y), s[3] * inv - bfhi(c.y));
        o.z = cvtpk(s[4] * inv - bflo(c.z), s[5] * inv - bfhi(c.z)); o.w = cvtpk(s[6] * inv - bflo(c.w), s[7] * inv - bfhi(c.w));
        *(u32x4*)(At + m * 264 + cg * 8) = o;
    }
    __syncthreads();
    {
        const int gi = wid >> 1, d0 = (wid & 1) * 32;
        const u16* W = (const u16*)(p.ws + OFF_WTPOOL) + (size_t)(l * 4 + gi) * 64 * 64;
        f32x16 acc[2];
#pragma unroll
        for (int i = 0; i < 2; ++i)
#pragma unroll
            for (int r = 0; r < 16; ++r) acc[i][r] = 0.f;
#pragma unroll
        for (int ks = 0; ks < 4; ++ks) {
            const bf16x8 bfr = *(const bf16x8*)(W + (size_t)(d0 + r32) * 64 + ks * 16 + hi * 8);
#pragma unroll
            for (int i = 0; i < 2; ++i) { const bf16x8 af = *(const bf16x8*)(At + (i * 32 + r32) * 264 + gi * 64 + ks * 16 + hi * 8); acc[i] = MFMA32(bfr, af, acc[i]); }
        }
#pragma unroll
        for (int i = 0; i < 2; ++i) {
            const size_t row = (size_t)(r0 + i * 32 + r32);
#pragma unroll
            for (int r4 = 0; r4 < 4; ++r4) {
                const int c = gi * 64 + d0 + 8 * r4 + 4 * hi;
                const f32x4 ps = *(const f32x4*)(p.pool_scale + l * 256 + c);
                const u32x2 gw = *(const u32x2*)(proj + row * NP + C_G + 256 + c);
                u32x2 w; w.x = cvtpk(POOL_OUT_SCALE * acc[i][4 * r4] * ps[0] * siluf_(bflo(gw.x)), POOL_OUT_SCALE * acc[i][4 * r4 + 1] * ps[1] * siluf_(bfhi(gw.x)));
                w.y = cvtpk(POOL_OUT_SCALE * acc[i][4 * r4 + 2] * ps[2] * siluf_(bflo(gw.y)), POOL_OUT_SCALE * acc[i][4 * r4 + 3] * ps[3] * siluf_(bfhi(gw.y)));
                *(u32x2*)(mix + row * DM + 256 + c) = w;
            }
        }
    }
}

DI void s5_unit_rows(int u, int& r0, int& b, int& cidx) {
    if (u < 256) { r0 = u * 128; b = u >> 6; cidx = 2 + (u & 63); } else { const int uc = u - 256; r0 = NLAT + uc * 128; b = uc >> 1; cidx = uc & 1; }
}
DI int s5_rev_order(int i) { return i == 0 ? 1 : (i == 1 ? 0 : 67 - i); }

DI void s5_bu(const bf16x8 ua, int r32, int hi, const bf16x8 (&bR)[2], const bf16x8 (&bI)[2], unsigned* slab) {
    f32x16 z;
#pragma unroll
    for (int r = 0; r < 16; ++r) z[r] = 0.f;
    const f32x16 re0 = MFMA32(ua, bR[0], z), im0 = MFMA32(ua, bI[0], z), re1 = MFMA32(ua, bR[1], z), im1 = MFMA32(ua, bI[1], z);
#pragma unroll
    for (int r = 0; r < 16; ++r) { const int t = crow(r, hi); slab[t * 68 + r32] = cvtpk(re0[r], im0[r]); slab[t * 68 + 32 + r32] = cvtpk(re1[r], im1[r]); }
    asm volatile("" ::: "memory");
}

template <int D, int STORE>
DI void s5_scan32(unsigned* slab, int lane, float lr, float li, float& hr, float& hi_) {
    const f32x2_ lrv = {lr, lr}, liv = {-li, li};
    f32x2_ h = {hr, hi_};
#pragma unroll
    for (int i0 = 0; i0 < 32; i0 += 16) {
        unsigned w[16];
#pragma unroll
        for (int k = 0; k < 16; ++k) { const int t = D ? 31 - (i0 + k) : i0 + k; w[k] = slab[t * 68 + lane]; }
#pragma unroll
        for (int k = 0; k < 16; ++k) {
            const int t = D ? 31 - (i0 + k) : i0 + k;
            const f32x2_ bu = {bflo(w[k]), bfhi(w[k])};
            const f32x2_ hs = __builtin_shufflevector(h, h, 1, 0);
            const f32x2_ inner = __builtin_elementwise_fma(liv, hs, bu);
            h = __builtin_elementwise_fma(lrv, h, inner);
            if (STORE) slab[t * 68 + lane] = cvtpk(h[0], h[1]);
        }
    }
    hr = h[0]; hi_ = h[1];
    asm volatile("" ::: "memory");
}

DI void s5_load_dir(const Params& p, int pidx, int lane, float& lr, float& li, bf16x8 (&bR)[2], bf16x8 (&bI)[2]) {
    const int r32 = lane & 31, hi = lane >> 5;
    lr = ((const float*)(p.ws + OFF_LB))[(pidx + lane) * 2]; li = ((const float*)(p.ws + OFF_LB))[(pidx + lane) * 2 + 1];
#pragma unroll
    for (int pb = 0; pb < 2; ++pb) { bR[pb] = *(const bf16x8*)((const u16*)(p.ws + OFF_BBR) + (size_t)(pidx + pb * 32 + r32) * 16 + hi * 8);
        bI[pb] = *(const bf16x8*)((const u16*)(p.ws + OFF_BBI) + (size_t)(pidx + pb * 32 + r32) * 16 + hi * 8); }
}

template <int D>
DI void s5_p1_dir(const Params& p, int l, int g, int lane, const bf16x8 (&ua)[4], unsigned* slab, float* ep) {
    const int r32 = lane & 31, hi = lane >> 5;
    float lr, li; bf16x8 bR[2], bI[2];
    s5_load_dir(p, ((l * 2 + D) * 16 + g) * 64, lane, lr, li, bR, bI);
    float hr = 0.f, hi_ = 0.f;
#pragma unroll
    for (int sc = 0; sc < 4; ++sc) {
        __builtin_amdgcn_sched_barrier(0);
        s5_bu(ua[D ? 3 - sc : sc], r32, hi, bR, bI, slab);
        __builtin_amdgcn_sched_barrier(0);
        s5_scan32<D, 0>(slab, lane, lr, li, hr, hi_);
    }
    ep[0] = hr; ep[1] = hi_;
}

DI void unit_s5_pass1(const Params& p, int l, int u, unsigned char* smem) {
    const int tid = otid(), wid = __builtin_amdgcn_readfirstlane(tid >> 6), lane = tid & 63, r32 = lane & 31, hi = lane >> 5;
    const u16* proj = (const u16*)(p.ws + OFF_PROJ);
    unsigned* slab = (unsigned*)(smem + wid * 8704);
    int r0, b, cidx; s5_unit_rows(u, r0, b, cidx);
    float* E = (float*)(p.ws + OFF_E);
    __syncthreads();
    bf16x8 ua[2][4];
#pragma unroll
    for (int gg = 0; gg < 2; ++gg)
#pragma unroll
        for (int sc = 0; sc < 4; ++sc) ua[gg][sc] = *(const bf16x8*)(proj + (size_t)(r0 + sc * 32 + r32) * NP + C_S5 + (wid * 2 + gg) * 16 + hi * 8);
#pragma unroll
    for (int gg = 0; gg < 2; ++gg) {
        const int g = wid * 2 + gg;
        s5_p1_dir<0>(p, l, g, lane, ua[gg], slab, E + ((size_t)((0 * 4 + b) * 66 + cidx) * 16 + g) * 128 + lane * 2);
        s5_p1_dir<1>(p, l, g, lane, ua[gg], slab, E + ((size_t)((1 * 4 + b) * 66 + cidx) * 16 + g) * 128 + lane * 2);
    }
}

DI void unit_s5_carry(const Params& p, int l, int u, unsigned* cnt) {
    const int tid = otid();
    const int id = u * 512 + tid;
    const int db = id >> 10, gp = id & 1023, d = db >> 2;
    const float* lb = (const float*)(p.ws + OFF_LB) + (size_t)(((l * 2 + d) * 16) * 64 + gp) * 2;
    float tr = lb[0], ti = lb[1];
#pragma unroll
    for (int i = 0; i < 7; ++i) { const float a = tr * tr - ti * ti, c = 2.f * tr * ti; tr = a; ti = c; }
    float* E = (float*)(p.ws + OFF_E) + ((size_t)db * 66 * 1024 + gp) * 2;
    float hr = 0.f, hi_ = 0.f; asm volatile("" : "+v"(hr), "+v"(hi_));
    for (int i0 = 0; i0 < 66; i0 += 11) {
        float er[11], ei[11];
#pragma unroll
        for (int k = 0; k < 11; ++k) { const int cj = d ? s5_rev_order(i0 + k) : i0 + k; const f32x2_ e = *(const f32x2_*)(E + (size_t)cj * 2048); er[k] = e[0]; ei[k] = e[1]; }
#pragma unroll
        for (int k = 0; k < 11; ++k) {
            const int cj = d ? s5_rev_order(i0 + k) : i0 + k;
            *(f32x2_*)(E + (size_t)cj * 2048) = (f32x2_){hr, hi_};
            const float nr = fmaf(tr, hr, fmaf(-ti, hi_, er[k])), ni = fmaf(tr, hi_, fmaf(ti, hr, ei[k])); hr = nr; hi_ = ni;
        }
    }
    asm volatile("s_waitcnt vmcnt(0)" ::: "memory");
    __syncthreads();
    if (tid == 0) { __threadfence(); __hip_atomic_fetch_add(cnt, 1u, __ATOMIC_RELEASE, __HIP_MEMORY_SCOPE_AGENT); }
}

template <int D>
DI void s5_p2_dir(const Params& p, int l, int g, int lane, const bf16x8 (&ua)[4], unsigned* slab, const float* ep, f32x4 (&Y)[8]) {
    const int r32 = lane & 31, hi = lane >> 5;
    float lr, li; bf16x8 bR[2], bI[2], cm[4];
    const int pidx = ((l * 2 + D) * 16 + g) * 64;
    s5_load_dir(p, pidx, lane, lr, li, bR, bI);
#pragma unroll
    for (int kb = 0; kb < 4; ++kb) cm[kb] = *(const bf16x8*)((const u16*)(p.ws + OFF_CM) + ((size_t)(pidx >> 6) * 16 + (lane & 15)) * 128 + kb * 32 + (lane >> 4) * 8);
    const unsigned long long ev = __hip_atomic_load((const unsigned long long*)ep, __ATOMIC_RELAXED, __HIP_MEMORY_SCOPE_AGENT);
    float hr = __uint_as_float((unsigned)ev), hi_ = __uint_as_float((unsigned)(ev >> 32));
    const unsigned char* sb = (const unsigned char*)slab;
#pragma unroll
    for (int sc = 0; sc < 4; ++sc) {
        const int SC = D ? 3 - sc : sc;
        __builtin_amdgcn_sched_barrier(0);
        s5_bu(ua[SC], r32, hi, bR, bI, slab);
        __builtin_amdgcn_sched_barrier(0);
        s5_scan32<D, 1>(slab, lane, lr, li, hr, hi_);
#pragma unroll
        for (int rb = 0; rb < 2; ++rb)
#pragma unroll
            for (int kb = 0; kb < 4; ++kb) {
                const bf16x8 a = *(const bf16x8*)(sb + (16 * rb + (lane & 15)) * 272 + kb * 64 + (lane >> 4) * 16);
                Y[2 * SC + rb] = MFMA16(a, cm[kb], Y[2 * SC + rb]);
            }
        asm volatile("" ::: "memory");
    }
}

DI void unit_s5_pass2(const Params& p, int l, int u, unsigned char* smem, const unsigned* cnt) {
    const int tid = otid(), wid = __builtin_amdgcn_readfirstlane(tid >> 6), lane = tid & 63, r32 = lane & 31, hi = lane >> 5;
    const u16* proj = (const u16*)(p.ws + OFF_PROJ); u16* mix = (u16*)(p.ws + OFF_H);
    unsigned* slab = (unsigned*)(smem + wid * 8704);
    u16* gy = (u16*)(smem + 8 * 8704);
    int r0, b, cidx; s5_unit_rows(u, r0, b, cidx);
    const float* E = (const float*)(p.ws + OFF_E);
    if (tid == 0) { while (__hip_atomic_load(cnt, __ATOMIC_RELAXED, __HIP_MEMORY_SCOPE_AGENT) < 16u) __builtin_amdgcn_s_sleep(8); }
    __syncthreads();
#pragma unroll
    for (int gg = 0; gg < 2; ++gg) {
        const int g = wid * 2 + gg;
        bf16x8 ua[4];
#pragma unroll
        for (int sc = 0; sc < 4; ++sc) ua[sc] = *(const bf16x8*)(proj + (size_t)(r0 + sc * 32 + r32) * NP + C_S5 + g * 16 + hi * 8);
        f32x4 Y[8];
#pragma unroll
        for (int i = 0; i < 8; ++i) Y[i] = (f32x4){0.f, 0.f, 0.f, 0.f};
        s5_p2_dir<0>(p, l, g, lane, ua, slab, E + ((size_t)((0 * 4 + b) * 66 + cidx) * 16 + g) * 128 + lane * 2, Y);
        s5_p2_dir<1>(p, l, g, lane, ua, slab, E + ((size_t)((1 * 4 + b) * 66 + cidx) * 16 + g) * 128 + lane * 2, Y);
        int lnb = lane; asm volatile("" : "+v"(lnb));
        const int c = g * 16 + (lnb & 15); const float dsk = p.s5_d[l * 256 + c];
#pragma unroll
        for (int i = 0; i < 8; ++i)
#pragma unroll
            for (int r = 0; r < 4; ++r) {
                const int t = 16 * i + (lnb >> 4) * 4 + r;
                const float y = Y[i][r] + bf2f(proj[(size_t)(r0 + t) * NP + C_S5 + c]) * dsk;
                gy[t * 264 + c] = f2bf(gelu_tanh(y));
            }
    }
    __syncthreads();
    {
        const int tid2 = otid(), r32 = tid2 & 31, hi = (tid2 >> 5) & 1;
        const int n0 = wid * 32;
        const u16* W = (const u16*)(p.ws + OFF_WTGLU) + (size_t)l * 256 * 256;
        f32x16 acc[4];
#pragma unroll
        for (int i = 0; i < 4; ++i)
#pragma unroll
            for (int r = 0; r < 16; ++r) acc[i][r] = 0.f;
        bf16x8 bfr[16];
#pragma unroll
        for (int ks = 0; ks < 16; ++ks) bfr[ks] = *(const bf16x8*)(W + (size_t)(n0 + r32) * 256 + ks * 16 + hi * 8);
#pragma unroll
        for (int ks = 0; ks < 16; ++ks) {
#pragma unroll
            for (int i = 0; i < 4; ++i) { const bf16x8 af = *(const bf16x8*)(gy + (i * 32 + r32) * 264 + ks * 16 + hi * 8); acc[i] = MFMA32(bfr[ks], af, acc[i]); }
        }
#pragma unroll
        for (int i = 0; i < 4; ++i) {
            const int t = i * 32 + r32; const size_t row = (size_t)(r0 + t);
#pragma unroll
            for (int r4 = 0; r4 < 4; ++r4) {
                const int n = n0 + 8 * r4 + 4 * hi;
                const f32x4 bg = *(const f32x4*)(p.b_glu + l * 256 + n);
                const u32x2 yw = *(const u32x2*)(gy + t * 264 + n), gw = *(const u32x2*)(proj + row * NP + C_G + 512 + n);
                const float o0 = bflo(yw.x) * sigmoidf_(acc[i][4 * r4] + bg[0]) * siluf_(bflo(gw.x)), o1 = bfhi(yw.x) * sigmoidf_(acc[i][4 * r4 + 1] + bg[1]) * siluf_(bfhi(gw.x));
                const float o2 = bflo(yw.y) * sigmoidf_(acc[i][4 * r4 + 2] + bg[2]) * siluf_(bflo(gw.y)), o3 = bfhi(yw.y) * sigmoidf_(acc[i][4 * r4 + 3] + bg[3]) * siluf_(bfhi(gw.y));
                u32x2 w; w.x = cvtpk(S5_OUT_SCALE * o0, S5_OUT_SCALE * o1); w.y = cvtpk(S5_OUT_SCALE * o2, S5_OUT_SCALE * o3);
                *(u32x2*)(mix + row * DM + 512 + n) = w;
            }
        }
    }
}

constexpr int AT_V = 64 * 64 * 2, AT_K = 64 * 256, AT_LDS = 2 * AT_V + 2 * AT_K + 8 * 64 * 4;
#ifndef ATT_OUT_SCALE
#define ATT_OUT_SCALE 1.f
#endif
constexpr float AT_THR = 11.5f;
#define KSWZ(row, colB) ((row) * 256 + ((colB) ^ (((row) & 7) << 4)))
#define SBAR() __builtin_amdgcn_sched_barrier(0)
#define LSBAR() do {} while (0)
template <bool FIRST>
DI void partialSM(f32x16& p0, f32x16& p1, float& m_reg, f32x16& negm, float& alpha) {
    float pmax = p0[0];
#pragma unroll
    for (int r = 1; r < 16; ++r) pmax = fmaxf(pmax, p0[r]);
#pragma unroll
    for (int r = 0; r < 16; ++r) pmax = fmaxf(pmax, p1[r]);
    { auto rr = __builtin_amdgcn_permlane32_swap(__float_as_uint(pmax), __float_as_uint(pmax), false, false);
      pmax = fmaxf(__uint_as_float(rr[0]), __uint_as_float(rr[1])); }
    if (!FIRST && __builtin_expect(__all(pmax <= AT_THR), 1)) { alpha = 1.f; }
    else {
        const float delta = FIRST ? pmax : fmaxf(pmax, 0.f);
        alpha = FIRST ? 1.f : fexp2(-delta); m_reg += delta;
#pragma unroll
        for (int r = 0; r < 16; ++r) { p0[r] -= delta; p1[r] -= delta; negm[r] = -m_reg; }
    }
#pragma unroll
    for (int r = 0; r < 16; ++r) p0[r] = fexp2(p0[r]);
}
DI void finishSM(f32x16& p0, f32x16& p1, bf16x8& pa0, bf16x8& pa1, bf16x8& pa2, bf16x8& pa3) {
#pragma unroll
    for (int r = 0; r < 16; ++r) p1[r] = fexp2(p1[r]);
#define PK4(P, BASE, OUT) do { unsigned a0 = cvtpk(P[BASE + 0], P[BASE + 1]), a1 = cvtpk(P[BASE + 2], P[BASE + 3]);   \
    unsigned b0 = cvtpk(P[BASE + 4], P[BASE + 5]), b1 = cvtpk(P[BASE + 6], P[BASE + 7]);                              \
    auto r0 = __builtin_amdgcn_permlane32_swap(a0, b0, false, false); auto r1 = __builtin_amdgcn_permlane32_swap(a1, b1, false, false); \
    u32x4 w = {r0[0], r1[0], r0[1], r1[1]}; OUT = *reinterpret_cast<bf16x8*>(&w); } while (0)
    PK4(p0, 0, pa0); PK4(p0, 8, pa1); PK4(p1, 0, pa2); PK4(p1, 8, pa3);
#undef PK4
}
DI void qkt(f32x16& p0, f32x16& p1, const unsigned char* Ks, const bf16x8* qr, int r32, int hi, const f32x16& negm) {
    p0 = negm; p1 = negm;
#pragma unroll
    for (int d0 = 0; d0 < 6; ++d0) { const int cb = (d0 * 16 + hi * 8) * 2;
        const bf16x8 b0 = *reinterpret_cast<const bf16x8*>(Ks + KSWZ(r32, cb));
        const bf16x8 b1 = *reinterpret_cast<const bf16x8*>(Ks + KSWZ(32 + r32, cb));
        p0 = MFMA32(b0, qr[d0], p0);
        p1 = MFMA32(b1, qr[d0], p1); }
}
DI int v_st(int k, int c) { const int kk = (k & ~0xC) | ((k & 4) << 1) | ((k & 8) >> 1); return ((kk >> 3) * 2 + (c >> 5)) * 512 + ((kk & 7) * 32 + (c & 31)) * 2; }
DI int v_rd_base(int lane) { return ((lane & 3) << 3) | (((lane >> 2) & 3) << 6) | (((lane >> 4) & 1) << 5) | (((lane >> 5) & 1) << 8); }
constexpr int v_rd_off(int d0, int ks, int half) { return d0 * 512 + ks * 2048 + half * 1024; }
template <int OFF> DI s16x4 tr_read(int vb) { s16x4 r; asm volatile("ds_read_b64_tr_b16 %0, %1 offset:%2" : "=&v"(r) : "v"(vb), "i"(OFF) : "memory"); return r; }
template <int D0> DI void pv_one(f32x16& od, int vb, bf16x8 pa0, bf16x8 pa1, bf16x8 pa2, bf16x8 pa3) {
    const s16x4 l0 = tr_read<v_rd_off(D0, 0, 0)>(vb), h0 = tr_read<v_rd_off(D0, 0, 1)>(vb), l1 = tr_read<v_rd_off(D0, 1, 0)>(vb), h1 = tr_read<v_rd_off(D0, 1, 1)>(vb);
    const s16x4 l2 = tr_read<v_rd_off(D0, 2, 0)>(vb), h2 = tr_read<v_rd_off(D0, 2, 1)>(vb), l3 = tr_read<v_rd_off(D0, 3, 0)>(vb), h3 = tr_read<v_rd_off(D0, 3, 1)>(vb);
    asm volatile("s_waitcnt lgkmcnt(0)" ::: "memory"); SBAR();
#define PK(L, H) (bf16x8){L[0], L[1], L[2], L[3], H[0], H[1], H[2], H[3]}
    od = MFMA32(pa0, PK(l0, h0), od);
    od = MFMA32(pa1, PK(l1, h1), od);
    od = MFMA32(pa2, PK(l2, h2), od);
    od = MFMA32(pa3, PK(l3, h3), od);
#undef PK
}
DI void pv_d0(f32x16* o, int vb, bf16x8 pa0, bf16x8 pa1, bf16x8 pa2, bf16x8 pa3) {
    pv_one<0>(o[0], vb, pa0, pa1, pa2, pa3); pv_one<1>(o[1], vb, pa0, pa1, pa2, pa3);
    const bf16x8 ones = {0x3F80, 0x3F80, 0x3F80, 0x3F80, 0x3F80, 0x3F80, 0x3F80, 0x3F80};
    o[2] = MFMA32(pa0, ones, o[2]); o[2] = MFMA32(pa1, ones, o[2]); o[2] = MFMA32(pa2, ones, o[2]); o[2] = MFMA32(pa3, ones, o[2]);
}

DI void attn_unit(const u16* __restrict__ Qb, const u16* __restrict__ Kh, const u16* __restrict__ Vh, int nkeys, int row0, int h, const Params& p, unsigned char* lds) {
    const int tid = otid(), wid = __builtin_amdgcn_readfirstlane(tid >> 6), lane = tid & 63, r32 = lane & 31, hi = lane >> 5;
    unsigned char* V_lds = lds; unsigned char* K_lds = lds + 2 * AT_V;
    float* wsl = (float*)(lds + 2 * AT_V + 2 * AT_K) + wid * 64; float* al_l = wsl + 32;
    float m_reg = 0.f; f32x16 o[3], negm; bf16x8 qr[6];
#pragma unroll
    for (int r = 0; r < 16; ++r) negm[r] = 0.f;
#pragma unroll
    for (int d = 0; d < 3; ++d)
#pragma unroll
        for (int r = 0; r < 16; ++r) o[d][r] = 0.f;
    const u16* Qw = Qb + (size_t)(wid * 32 + r32) * 96 + hi * 8;
#pragma unroll
    for (int d0 = 0; d0 < 6; ++d0) qr[d0] = *(const bf16x8*)(Qw + d0 * 16);
    const int vst = v_st(tid >> 3, (tid & 7) * 8);
    const int kc0 = tid, kc1 = 512 + (tid & 255);
    const int kst0 = KSWZ(kc0 / 12, (kc0 % 12) * 16), kst1 = KSWZ(kc1 / 12, (kc1 % 12) * 16);
    const bool k2 = tid < 256;
    const int vb0 = (int)(uintptr_t)V_lds + v_rd_base(lane);
    struct { bf16x8 vs, ks0, ks1; } sr_[2];
#define SLOAD(i, k0) do { sr_[i].vs = *(const bf16x8*)(Vh + (size_t)(k0) * 64 + tid * 8); sr_[i].ks0 = *(const bf16x8*)(Kh + (size_t)(k0) * 96 + kc0 * 8); \
    sr_[i].ks1 = *(const bf16x8*)(Kh + (size_t)(k0) * 96 + kc1 * 8); } while (0)
#define SWRITE(b, i) do { *(bf16x8*)(V_lds + (b) * AT_V + vst) = sr_[i].vs; *(bf16x8*)(K_lds + (b) * AT_K + kst0) = sr_[i].ks0; \
    if (k2) *(bf16x8*)(K_lds + (b) * AT_K + kst1) = sr_[i].ks1; } while (0)
#define SWAIT() asm volatile("s_waitcnt vmcnt(3)" ::: "memory")
#define RESC(a) do { if (__any((a) < 1.f)) { if (hi == 0) al_l[r32] = (a); asm volatile("s_waitcnt lgkmcnt(0)" ::: "memory"); \
    _Pragma("unroll") for (int d = 0; d < 3; ++d) _Pragma("unroll") for (int r = 0; r < 16; ++r) o[d][r] *= al_l[crow(r, hi)]; } } while (0)
    f32x16 pA0, pA1, pB0, pB1; float alA, alB; bf16x8 pa0, pa1, pa2, pa3; const int NT = nkeys / 64;
    constexpr int SE = 0, SO = 1;
    __syncthreads();
    SLOAD(SE, 0); asm volatile("s_waitcnt vmcnt(0)" ::: "memory"); SWRITE(0, SE); __syncthreads();
    qkt(pA0, pA1, K_lds, qr, r32, hi, negm); partialSM<true>(pA0, pA1, m_reg, negm, alA);
    SLOAD(SO, 64); if (2 < NT) SLOAD(SE, 128);
    SWAIT(); SWRITE(1, SO); __syncthreads();
    for (int j = 1; j + 1 < NT; j += 2) {
        LSBAR(); qkt(pB0, pB1, K_lds + AT_K, qr, r32, hi, negm);
        finishSM(pA0, pA1, pa0, pa1, pa2, pa3); LSBAR();
        SLOAD(SO, (j + 2) * 64); LSBAR();
        pv_d0(o, vb0, pa0, pa1, pa2, pa3); partialSM<false>(pB0, pB1, m_reg, negm, alB);
        __syncthreads(); SWAIT(); SWRITE(0, SE);
        RESC(alB); __syncthreads();
        LSBAR(); qkt(pA0, pA1, K_lds, qr, r32, hi, negm);
        finishSM(pB0, pB1, pa0, pa1, pa2, pa3); LSBAR();
        if (j + 3 < NT) SLOAD(SE, (j + 3) * 64); LSBAR();
        pv_d0(o, vb0 + AT_V, pa0, pa1, pa2, pa3); partialSM<false>(pA0, pA1, m_reg, negm, alA);
        __syncthreads(); SWAIT(); SWRITE(1, SO);
        RESC(alA); __syncthreads();
    }
    LSBAR(); qkt(pB0, pB1, K_lds + AT_K, qr, r32, hi, negm);
    finishSM(pA0, pA1, pa0, pa1, pa2, pa3); LSBAR();
    pv_d0(o, vb0, pa0, pa1, pa2, pa3); partialSM<false>(pB0, pB1, m_reg, negm, alB);
    __syncthreads(); RESC(alB);
    finishSM(pB0, pB1, pa0, pa1, pa2, pa3); LSBAR();
    pv_d0(o, vb0 + AT_V, pa0, pa1, pa2, pa3);
    const u16* proj = (const u16*)(p.ws + OFF_PROJ); u16* mix = (u16*)(p.ws + OFF_H);
#pragma unroll
    for (int r = 0; r < 16; ++r) {
        const int orow = row0 + wid * 32 + crow(r, hi); const float rl = __builtin_amdgcn_rcpf(o[2][r]);
#pragma unroll
        for (int d0 = 0; d0 < 2; ++d0) {
            const int c = h * 64 + d0 * 32 + r32;
            const float gt = bf2f(proj[(size_t)orow * NP + C_G + c]);
            mix[(size_t)orow * DM + c] = f2bf(ATT_OUT_SCALE * o[d0][r] * rl * siluf_(gt));
        }
    }
#undef SLOAD
#undef SWRITE
#undef SWAIT
#undef RESC
}
#define XB_TMO      128
#define XB_XCNT(j)  (256  + 64 * (j))
#define XB_XSUB(j)  (1280 + 64 * (j))
#define XB_XGEN(j)  (2304 + 64 * (j))
#define XB_TOP      3328
#define XB_TOPGEN   3392
#define XCD_BAR_WORDS 3456
#define XB_SPIN_CAP (1u << 18)
#define LAS __attribute__((address_space(3)))

__device__ __forceinline__ unsigned xb_ld(unsigned* p)              { return __hip_atomic_load(p, __ATOMIC_RELAXED, __HIP_MEMORY_SCOPE_AGENT); }
__device__ __forceinline__ unsigned xb_add(unsigned* p, unsigned v) { return __hip_atomic_fetch_add(p, v, __ATOMIC_RELAXED, __HIP_MEMORY_SCOPE_AGENT); }
__device__ __forceinline__ unsigned xb_xcc_id() { return (unsigned)__builtin_amdgcn_s_getreg((3 << 11) | 20) & 0xFu; }
#define XB_SPIN(cond, bar) do { unsigned _sp = 0; while (cond) { __builtin_amdgcn_s_sleep(1); \
    if ((++_sp & 255u) == 0u) { if (xb_ld(&(bar)[XB_TMO])) break; if (_sp > XB_SPIN_CAP) { atomicAdd(&(bar)[XB_TMO], 1u); break; } } } } while (0)

struct XcdBarrier {
    unsigned* bar; unsigned x;
    volatile LAS unsigned* st;
};

__device__ __forceinline__ XcdBarrier xcd_barrier_post(unsigned* bar, volatile LAS unsigned* st) {
    XcdBarrier b; b.bar = bar; b.x = xb_xcc_id(); b.st = st;
    if (threadIdx.x == 0) (void)xb_add(&bar[XB_XCNT(b.x)], 1u);
    return b;
}
__device__ __forceinline__ void xcd_barrier_complete(unsigned* bar, unsigned x, unsigned& nloc, unsigned& nx) {
    const unsigned G = gridDim.x * gridDim.y * gridDim.z;
    unsigned sum, cnt, mine, sp = 0u;
    for (;;) {
        sum = 0u; cnt = 0u; mine = 0u;
#pragma unroll
        for (unsigned j = 0; j < 16; ++j) { const unsigned c = xb_ld(&bar[XB_XCNT(j)]); sum += c; cnt += (c > 0u) ? 1u : 0u; mine = (j == x) ? c : mine; }
        if (sum == G) break;
        __builtin_amdgcn_s_sleep(1);
        if ((++sp & 255u) == 0u) { if (xb_ld(&bar[XB_TMO])) break; if (sp > XB_SPIN_CAP) { atomicAdd(&bar[XB_TMO], 1u); break; } }
    }
    nloc = mine > 0u ? mine : 1u; nx = cnt > 0u ? cnt : 1u;
}

__device__ __forceinline__ void xcd_barrier(const XcdBarrier& b) {
    asm volatile("s_waitcnt vmcnt(0)" ::: "memory");
    __syncthreads();
    if (threadIdx.x == 0) {
        unsigned* bar = b.bar;
        __builtin_amdgcn_s_waitcnt(0);
        unsigned nloc = b.st[0], nx = b.st[1];
        if (nloc == 0u) { xcd_barrier_complete(bar, b.x, nloc, nx); b.st[0] = nloc; b.st[1] = nx; }
        const unsigned old = xb_add(&bar[XB_XSUB(b.x)], 1u);
        const unsigned gen = old / nloc;
        if (old + 1u == (gen + 1u) * nloc) {
            __builtin_amdgcn_fence(__ATOMIC_RELEASE, "agent");
            asm volatile("s_waitcnt vmcnt(0)" ::: "memory");
            const unsigned og = xb_add(&bar[XB_TOP], 1u);
            const unsigned tg = og / nx;
            if (og + 1u == (tg + 1u) * nx) xb_add(&bar[XB_TOPGEN], 1u);
            else XB_SPIN(xb_ld(&bar[XB_TOPGEN]) == tg, bar);
            __builtin_amdgcn_fence(__ATOMIC_ACQUIRE, "agent");
            xb_add(&bar[XB_XGEN(b.x)], 1u);
            asm volatile("s_waitcnt vmcnt(0)" ::: "memory");
        } else {
            XB_SPIN(xb_ld(&bar[XB_XGEN(b.x)]) == gen, bar);
            __builtin_amdgcn_fence(__ATOMIC_ACQUIRE, "agent");
            asm volatile("s_waitcnt vmcnt(0)" ::: "memory");
        }
    }
    __syncthreads();
}

#ifndef RC_S5
#define RC_S5 1
#endif
#ifndef RC_SGU
#define RC_SGU 1
#endif
#ifndef RC_MLA
#define RC_MLA 1
#endif
#ifndef RC_POOL
#define RC_POOL 1
#endif
DI void phase_c(const Params& p, int l, unsigned char* smem) {
    const int last = (l == 1);
    const int n_g = last ? 8 : 40, n_s5c = 8, n_sguc = last ? 0 : 8, n_mlac = 16, n_poolc = last ? 0 : 16;
    const int total = n_g + 256 + 256 + 512 + 512 + n_s5c + n_sguc + n_mlac + n_poolc;
    unsigned* queue = (unsigned*)(p.ws + OFF_CNT) + 32 + l * 16;
    unsigned* gdone = (unsigned*)(p.ws + OFF_CNT) + 8 + l * 4;
    volatile LAS int* nx = (volatile LAS int*)(smem + LDS_BYTES - 4);
    int u = blockIdx.x;
    while (u < total) {
        int nxt = 0;
        if (threadIdx.x == 0) nxt = (int)gridDim.x + (int)__hip_atomic_fetch_add(queue, 1u, __ATOMIC_RELAXED, __HIP_MEMORY_SCOPE_AGENT);
        int v = u;
        if (v < n_g) unit_gemm_ctx(p, l, v, smem, gdone);
        else if ((v -= n_g) < 256) unit_s5_pass1(p, l, v, smem);
        else if ((v -= 256) < 256) unit_sgu(p, l, v, smem);
        else if ((v -= 256) < 512) unit_mla(p, l, v, smem);
        else if ((v -= 512) < 512) unit_pool(p, l, v, smem);
        else {
            v -= 512;
            if (threadIdx.x == 0) { while (__hip_atomic_load(gdone, __ATOMIC_RELAXED, __HIP_MEMORY_SCOPE_AGENT) < (unsigned)n_g) __builtin_amdgcn_s_sleep(8); }
            __syncthreads();
            asm volatile("buffer_inv sc1\n\ts_waitcnt vmcnt(0)" ::: "memory");
            if (v < n_s5c) unit_s5_pass1(p, l, 256 + v, smem);
            else if ((v -= n_s5c) < n_sguc) unit_sgu(p, l, 256 + v, smem);
            else if ((v -= n_sguc) < n_mlac) unit_mla(p, l, 512 + v, smem);
            else unit_pool(p, l, 512 + (v - n_mlac), smem);
        }
        if (threadIdx.x == 0) nx[0] = nxt;
        __syncthreads();
        u = __builtin_amdgcn_readfirstlane(nx[0]);
    }
}

#ifndef RD_ATT
#define RD_ATT 1
#endif
#ifndef RD_S5
#define RD_S5 1
#endif
DI void phase_d(const Params& p, int l, unsigned char* smem) {
    const int last = (l == 1);
    const u16* Qg = (const u16*)(p.ws + OFF_Q); const u16* Kg = (const u16*)(p.ws + OFF_K); const u16* Vg = (const u16*)(p.ws + OFF_V);
    unsigned* cnt = (unsigned*)(p.ws + OFF_CNT) + l * 16;
    for (int uu = blockIdx.x; uu < 16 + 512; uu += gridDim.x) {
        if (uu < 16) { unit_s5_carry(p, l, uu, cnt); continue; }
        const int u = uu - 16;
        const int bh = (u & 7) + 8 * (u >> 8), qb = (u >> 3) & 31, b = bh >> 2, h = bh & 3;
        for (int q = 0; q < RD_ATT; ++q) attn_unit(Qg + ((size_t)bh * SKV + 256 + qb * 256) * 96, Kg + (size_t)bh * SKV * 96, Vg + (size_t)bh * SKV * 64, SKV, b * SEQ + qb * 256, h, p, smem);
    }
    const int n_cs5 = last ? 0 : 8, n_catt = last ? 0 : 16, n_ge = last ? 0 : 16;
    const int total = n_cs5 + n_catt + 256 + n_ge;
    unsigned* queue = (unsigned*)(p.ws + OFF_CNT) + 36 + l * 16;
    unsigned* mixdone = (unsigned*)(p.ws + OFF_CNT) + 10;
    volatile LAS int* nx = (volatile LAS int*)(smem + LDS_BYTES - 4);
    int u = blockIdx.x;
    while (u < total) {
        int nxt = 0;
        if (threadIdx.x == 0) nxt = (int)gridDim.x + (int)__hip_atomic_fetch_add(queue, 1u, __ATOMIC_RELAXED, __HIP_MEMORY_SCOPE_AGENT);
        int v = u;
        if (v < n_cs5) { unit_s5_pass2(p, l, 256 + v, smem, cnt); publish_unit(mixdone); }
        else if ((v -= n_cs5) < n_catt) {
            const int b = v >> 2, h = v & 3;
            attn_unit(Qg + (size_t)v * SKV * 96, Kg + (size_t)v * SKV * 96, Vg + (size_t)v * SKV * 64, CTXL, NLAT + b * CTXL, h, p, smem);
            publish_unit(mixdone);
        }
        else if ((v -= n_catt) < 256) { for (int q = 0; q < RD_S5; ++q) unit_s5_pass2(p, l, v, smem, cnt); }
        else { v -= 256; wait_units(mixdone, 24u); unit_gemm_one((const u16*)(p.ws + OFF_H), (const u16*)(p.ws + OFF_WTOUT), (u16*)(p.ws + OFF_Y), DM, 128 + (v >> 2), v & 3, smem); }
        if (threadIdx.x == 0) nx[0] = nxt;
        __syncthreads();
        u = __builtin_amdgcn_readfirstlane(nx[0]);
    }
}

DI void gsync(const XcdBarrier& b) { xcd_barrier(b); }
DI void gsync_cg(cg::grid_group& g) {
    asm volatile("s_waitcnt vmcnt(0) lgkmcnt(0)" ::: "memory");
    g.sync();
    asm volatile("buffer_inv sc1\n\ts_waitcnt vmcnt(0)" ::: "memory");
}
#ifndef REP_SYNC
#define REP_SYNC 0
#endif
#ifndef REP_W
#define REP_W 1
#endif
#ifndef REP_A
#define REP_A 1
#endif
#ifndef REP_B
#define REP_B 1
#endif
#ifndef REP_C
#define REP_C 1
#endif
#ifndef REP_D
#define REP_D 1
#endif
#ifndef REP_E
#define REP_E 1
#endif
#ifndef REP_F
#define REP_F 1
#endif
__global__ void __launch_bounds__(512) fwd_megakernel(Params p) {
    extern __shared__ __attribute__((aligned(16))) unsigned char smem[];
    cg::grid_group grid = cg::this_grid();
    volatile LAS unsigned* xst = (volatile LAS unsigned*)(smem + LDS_BYTES - 16);
    if (threadIdx.x < 4) xst[threadIdx.x] = 0u;
    __syncthreads();
    const XcdBarrier xb = xcd_barrier_post((unsigned*)(p.ws + OFF_BAR), xst);
    u16* hb = (u16*)(p.ws + OFF_H); u16* proj = (u16*)(p.ws + OFF_PROJ); u16* yb = (u16*)(p.ws + OFF_Y);
    if (p.ws == nullptr) gsync_cg(grid);
    for (int rep = 0; rep < REP_W; ++rep) { phase_w(p, smem); gsync(xb); }
    for (int rep = 0; rep < REP_A; ++rep) { phase_a(p, smem); gsync(xb); }
    for (int rep = 0; rep < REP_SYNC; ++rep) gsync(xb);
    for (int l = 0; l < 2; ++l) {
        for (int rep = 0; rep < REP_B; ++rep) { phase_gemm(hb, (const u16*)(p.ws + OFF_WTIN) + (size_t)l * NP * DM, proj, NLAT, NP, NP, smem); gsync(xb); }
        for (int rep = 0; rep < REP_C; ++rep) { phase_c(p, l, smem); gsync(xb); }
        for (int rep = 0; rep < REP_D; ++rep) { phase_d(p, l, smem); gsync(xb); }
        for (int rep = 0; rep < REP_E; ++rep) { phase_gemm(hb, (const u16*)(p.ws + OFF_WTOUT) + (size_t)l * DM * DM, yb, NLAT, DM, DM, smem); gsync(xb); }
        if (l == 0) { for (int rep = 0; rep < REP_F; ++rep) { phase_f(p, l, smem); gsync(xb); } } else phase_f(p, l, smem);
    }
}

extern "C" void kernel_launch(void* const* d_in, const int* in_sizes, int n_in, void* d_out, int out_size, void* d_ws, size_t ws_size, hipStream_t stream) {
    static int grid_blocks = 0;
    if (grid_blocks == 0) {
        if (n_in != 30 || out_size != NLAT * DM || ws_size < WS_END) { fprintf(stderr, "kernel_launch: unexpected shapes (n_in %d out %d ws %zu need %zu)\n", n_in, out_size, ws_size, (size_t)WS_END); grid_blocks = -1; return; }
        int dev = 0, cus = 0, per_cu = 0;
        hipGetDevice(&dev);
        hipDeviceGetAttribute(&cus, hipDeviceAttributeMultiprocessorCount, dev);
        if (hipFuncSetAttribute((const void*)fwd_megakernel, hipFuncAttributeMaxDynamicSharedMemorySize, LDS_BYTES) != hipSuccess) { fprintf(stderr, "kernel_launch: hipFuncSetAttribute failed\n"); grid_blocks = -1; return; }
        hipOccupancyMaxActiveBlocksPerMultiprocessor(&per_cu, (const void*)fwd_megakernel, 512, LDS_BYTES);
        if (per_cu < 1) { fprintf(stderr, "kernel_launch: occupancy query says %d blocks per CU\n", per_cu); per_cu = 1; }
        grid_blocks = cus * per_cu;
    }
    if (grid_blocks < 0) return;
    if (hipMemsetAsync((char*)d_ws + OFF_BAR, 0, BAR_BYTES, stream) != hipSuccess) { fprintf(stderr, "kernel_launch: hipMemsetAsync failed\n"); return; }
    Params p{};
    const float** pp = (const float**)&p;
    for (int i = 0; i < 30; ++i) pp[i] = (const float*)d_in[i];
    p.out = (float*)d_out; p.ws = (unsigned char*)d_ws;
    void* args[] = {&p};
    hipError_t e = hipLaunchCooperativeKernel((const void*)fwd_megakernel, dim3(grid_blocks), dim3(512), args, LDS_BYTES, stream);
    if (e != hipSuccess) fprintf(stderr, "cooperative launch failed: %s (grid %d)\n", hipGetErrorString(e), grid_blocks);
}
```

```cpp
#include <hip/hip_runtime.h>
#include <hip/hip_cooperative_groups.h>
#include <cstdio>
#include <cstdint>
namespace cg = cooperative_groups;
namespace pg8 {
#define PG8_LAS __attribute__((address_space(3)))
typedef unsigned short bf16_t;
typedef short bf16x8 __attribute__((ext_vector_type(8)));
typedef float f32x4 __attribute__((ext_vector_type(4)));
typedef unsigned u32x4 __attribute__((ext_vector_type(4)));
constexpr int BM = 256, BK = 64, HALF = 128, HTB = HALF * BK * 2  , STAGE_BYTES = 8 * HTB, NXCD = 8, WGM = 8;

__host__ __device__ __forceinline__ int lds_byte(int r, int c) { const int st = (r >> 4) * 2 + (c >> 5), rr = r & 15, cc = c & 31, ob = rr * 64 + cc * 2; return st * 1024 + (ob ^ (((ob >> 9) & 1) << 5)); }
__host__ __device__ __forceinline__ void stage_rc(int b, int& R, int& C) { const int st = b / 1024, sb = b % 1024, swz = sb ^ (((sb >> 9) & 1) << 5); R = (st >> 1) * 16 + swz / 64; C = (st & 1) * 32 + (swz % 64) / 2; }
__host__ __device__ __forceinline__ int perm32(int rho) { const int n = rho >> 4, i = rho & 15; return 8 * (i >> 2) + 4 * n + (i & 3); }

struct Unit { int pm, pn; };
struct Gemm { const bf16_t* A; const bf16_t* Bt; int M, N, K; };

struct StaticOrder {
    int nM, nN, nwg, G, c;
    __host__ __device__ void init(int M, int N, int G_, int c_) { nM = M / BM; nN = N / BM; nwg = nM * nN; G = G_; c = c_; }
    __host__ __device__ bool next(int i, Unit& u) const {
        const long L = (long)i * G + c; if (L >= nwg) return false;
        int wgid = (int)L; { const int q = nwg / NXCD, r = nwg % NXCD, xcd = wgid % NXCD, off = wgid / NXCD; wgid = (xcd < r ? xcd * (q + 1) : r * (q + 1) + (xcd - r) * q) + off; }
        const int nig = WGM * nN, gid = wgid / nig, fm = gid * WGM, gsz = (nM - fm) < WGM ? (nM - fm) : WGM;
        u.pm = fm + ((wgid % nig) % gsz); u.pn = (wgid % nig) / gsz; return true;
    }
    __device__ __forceinline__ void a_ready(const Unit&) const {}
    __device__ __forceinline__ void done(const Unit&) const {}
};
typedef float f32x2v __attribute__((ext_vector_type(2))); typedef __bf16 bf16x2v __attribute__((ext_vector_type(2)));
__device__ __forceinline__ unsigned cvt_pk_bf16(float lo, float hi) { const f32x2v v = {lo, hi}; const bf16x2v b = __builtin_convertvector(v, bf16x2v); return __builtin_bit_cast(unsigned, b); }
template <class Epi, class Sched, bool STAMP = false>
__device__ __forceinline__ void gemm_phase(PG8_LAS unsigned char* lds, const Gemm g, const Sched& S, const Epi& E, unsigned long long* stamps) {
    int tid = threadIdx.x; asm volatile("" : "+v"(tid)); const int wid = __builtin_amdgcn_readfirstlane(tid >> 6), lane = tid & 63, wr = wid >> 2, wc = wid & 3, fr = lane & 15, fq = lane >> 4;
    const int K = g.K, nt = K / BK;
    int ts_lo = 0, ts_hi = 0, nts = 0; const unsigned long long rt_entry = STAMP ? (unsigned long long)wall_clock64() : 0ull;
#define PG8_STAMP() do { if (STAMP && wid == 0 && nts < 64) { const unsigned long long _c = (unsigned long long)clock64(); \
        ts_lo = (lane == nts) ? (int)(unsigned)_c : ts_lo; ts_hi = (lane == nts) ? (int)(unsigned)(_c >> 32) : ts_hi; ++nts; } } while (0)
    PG8_STAMP();
    unsigned voffA[2], voffB[2];
#pragma unroll
    for (int i = 0; i < 2; ++i) { int R, C; stage_rc(tid * 16 + i * 8192, R, C); const int Rb = Epi::PERM ? ((R & ~31) + perm32(R & 31)) : R;
        voffA[i] = (unsigned)(R * K + C) * 2u; voffB[i] = (unsigned)(Rb * K + C) * 2u; }
    const size_t kstep = (size_t)(BK * 2);
    const size_t hstep = (size_t)HALF * K * 2;
    const size_t tstep = 2 * hstep;
    const unsigned ldsw = (unsigned)wid * 1024u;
    const int aoff = lds_byte(wr * 64 + fr, fq * 8), boff = lds_byte(wc * 32 + fr, fq * 8);
#define PG8_SA(b, h) (((b) * 2 + (h)) * HTB)
#define PG8_SB(b, h) ((4 + (b) * 2 + (h)) * HTB)
#define PG8_STAGE(bufoff, gbase, voff) do { _Pragma("unroll") for (int _i = 0; _i < 2; ++_i) \
        __builtin_amdgcn_global_load_lds((const unsigned*)((const char*)(gbase) + (voff)[_i]), (PG8_LAS unsigned*)(lds + (bufoff) + ldsw + _i * 8192), 16, 0, 0); } while (0)
#define PG8_LDA(dst, b, h) do { _Pragma("unroll") for (int m = 0; m < 4; ++m) _Pragma("unroll") for (int k = 0; k < 2; ++k) dst[m][k] = *(const PG8_LAS bf16x8*)(lds + PG8_SA(b, h) + aoff + m * 2048 + k * 1024); } while (0)
#define PG8_LDB(dst, b, h) do { _Pragma("unroll") for (int n = 0; n < 2; ++n) _Pragma("unroll") for (int k = 0; k < 2; ++k) dst[n][k] = *(const PG8_LAS bf16x8*)(lds + PG8_SB(b, h) + boff + n * 2048 + k * 1024); } while (0)
#define PG8_MMA(ai, bj, At, Bt) do { __builtin_amdgcn_s_setprio(1); _Pragma("unroll") for (int m = 0; m < 4; ++m) _Pragma("unroll") for (int n = 0; n < 2; ++n) _Pragma("unroll") for (int k = 0; k < 2; ++k) \
        acc[ai][bj][m][n] = __builtin_amdgcn_mfma_f32_16x16x32_bf16(Bt[n][k], At[m][k], acc[ai][bj][m][n], 0, 0, 0); __builtin_amdgcn_s_setprio(0); } while (0)
#define PG8_WAIT_V(n) asm volatile("s_waitcnt vmcnt(" #n ")" ::: "memory")
#define PG8_WAIT_L(n) asm volatile("s_waitcnt lgkmcnt(" #n ")" ::: "memory")
#define PG8_BAR __builtin_amdgcn_s_barrier()
#define PG8_SCHED __builtin_amdgcn_sched_barrier(0)
    Unit cur, nxt; int ui = 0;
    if (!S.next(0, cur)) return;
    f32x4 acc[2][2][4][2];
#pragma unroll
    for (int a = 0; a < 2; ++a)
#pragma unroll
        for (int b = 0; b < 2; ++b)
#pragma unroll
            for (int m = 0; m < 4; ++m)
#pragma unroll
                for (int n = 0; n < 2; ++n) acc[a][b][m][n] = (f32x4){0.f, 0.f, 0.f, 0.f};
    bf16x8 At[4][2], B0[2][2], B1[2][2];
    const char* cA = (const char*)g.A + (size_t)cur.pm * tstep; const char* cB = (const char*)g.Bt + (size_t)cur.pn * tstep;
    S.a_ready(cur);
    PG8_STAGE(PG8_SB(0, 0), cB, voffB); PG8_STAGE(PG8_SA(0, 0), cA, voffA); PG8_STAGE(PG8_SB(0, 1), cB + hstep, voffB); PG8_STAGE(PG8_SA(0, 1), cA + hstep, voffA);
    if (wr == 1) PG8_BAR;
    PG8_WAIT_V(4); PG8_BAR;
    PG8_STAGE(PG8_SB(1, 0), cB + kstep, voffB); PG8_STAGE(PG8_SA(1, 0), cA + kstep, voffA); PG8_STAGE(PG8_SB(1, 1), cB + hstep + kstep, voffB);
    PG8_WAIT_V(6); PG8_BAR;
    PG8_STAMP();
    for (;;) {
        const bool has_next = S.next(ui + 1, nxt);
        const char* nA = has_next ? (const char*)g.A + (size_t)nxt.pm * tstep : cA; const char* nB = has_next ? (const char*)g.Bt + (size_t)nxt.pn * tstep : cB;
        for (int t = 0; t < nt; t += 2) {
            const bool last = (t == nt - 2);
            const char* a1 = cA + (size_t)(t + 1) * kstep;
            const char* a2 = last ? nA : cA + (size_t)(t + 2) * kstep; const char* b2 = last ? nB : cB + (size_t)(t + 2) * kstep;
            const char* a3 = a2 + kstep; const char* b3 = b2 + kstep;
            if (last && has_next) S.a_ready(nxt);
            PG8_LDB(B0, 0, 0); PG8_SCHED; PG8_LDA(At, 0, 0); PG8_STAGE(PG8_SA(1, 1), a1 + hstep, voffA);
            PG8_WAIT_L(8); PG8_BAR; PG8_WAIT_L(0); PG8_MMA(0, 0, At, B0); PG8_BAR; PG8_SCHED;
            PG8_LDB(B1, 0, 1); PG8_STAGE(PG8_SB(0, 0), b2, voffB);
            PG8_BAR; PG8_WAIT_L(0); PG8_MMA(0, 1, At, B1); PG8_BAR;
            PG8_LDA(At, 0, 1); PG8_STAGE(PG8_SA(0, 0), a2, voffA);
            PG8_BAR; PG8_WAIT_L(0); PG8_MMA(1, 0, At, B0); PG8_BAR; PG8_SCHED;
            PG8_STAGE(PG8_SB(0, 1), b2 + hstep, voffB);
            PG8_WAIT_V(6); PG8_BAR; PG8_MMA(1, 1, At, B1); PG8_BAR;
            PG8_LDB(B0, 1, 0); PG8_SCHED; PG8_LDA(At, 1, 0); PG8_STAGE(PG8_SA(0, 1), a2 + hstep, voffA);
            PG8_WAIT_L(8); PG8_BAR; PG8_WAIT_L(0); PG8_MMA(0, 0, At, B0); PG8_BAR; PG8_SCHED;
            PG8_LDB(B1, 1, 1); PG8_STAGE(PG8_SB(1, 0), b3, voffB);
            PG8_BAR; PG8_WAIT_L(0); PG8_MMA(0, 1, At, B1); PG8_BAR;
            PG8_LDA(At, 1, 1); PG8_STAGE(PG8_SA(1, 0), a3, voffA);
            PG8_BAR; PG8_WAIT_L(0); PG8_MMA(1, 0, At, B0); PG8_BAR; PG8_SCHED;
            PG8_STAGE(PG8_SB(1, 1), b3 + hstep, voffB);
            PG8_WAIT_V(6); PG8_BAR; PG8_MMA(1, 1, At, B1); PG8_BAR;
        }
        PG8_STAMP();
        if constexpr (!Epi::AFTER_DRAIN) { E(acc, cur, wr, wc, fr, fq); S.done(cur); }
        PG8_STAMP();
        if (!has_next) break;
#pragma unroll
        for (int a = 0; a < 2; ++a)
#pragma unroll
            for (int b = 0; b < 2; ++b)
#pragma unroll
                for (int m = 0; m < 4; ++m)
#pragma unroll
                    for (int n = 0; n < 2; ++n) acc[a][b][m][n] = (f32x4){0.f, 0.f, 0.f, 0.f};
        cur = nxt; cA = nA; cB = nB; ++ui;
    }
    PG8_WAIT_V(0);
    if (wr == 0) PG8_BAR;
    PG8_BAR;
    if constexpr (Epi::AFTER_DRAIN) { E.fused(acc, cur, wr, wc, fr, fq, lds, wid, lane); S.done(cur); }
    PG8_STAMP();
    if (STAMP && wid == 0) { stamps[lane] = lane < nts ? (((unsigned long long)(unsigned)ts_hi << 32) | (unsigned)ts_lo) : 0ull;
        if (lane == 62) stamps[62] = rt_entry; if (lane == 63) stamps[63] = (unsigned long long)wall_clock64(); }
#undef PG8_STAMP
#undef PG8_SA
#undef PG8_SB
#undef PG8_STAGE
#undef PG8_LDA
#undef PG8_LDB
#undef PG8_MMA
#undef PG8_WAIT_V
#undef PG8_WAIT_L
#undef PG8_BAR
#undef PG8_SCHED
}
}
namespace pg8 {
struct EpiStoreBf16 {
    static constexpr bool PERM = true, AFTER_DRAIN = false;
    bf16_t* O; int ldc;
    __device__ __forceinline__ void operator()(const f32x4 (&acc)[2][2][4][2], const Unit& u, int wr, int wc, int fr, int fq) const {
        const int row0 = u.pm * BM + wr * 64 + fr; const int col0 = u.pn * BM + wc * 32 + 8 * fq;
#pragma unroll
        for (int ai = 0; ai < 2; ++ai)
#pragma unroll
            for (int m = 0; m < 4; ++m) { bf16_t* rowp = O + (size_t)(row0 + ai * HALF + m * 16) * ldc + col0;
#pragma unroll
                for (int bj = 0; bj < 2; ++bj) { const f32x4 v0 = acc[ai][bj][m][0], v1 = acc[ai][bj][m][1];
                    u32x4 w; w.x = cvt_pk_bf16(v0[0], v0[1]); w.y = cvt_pk_bf16(v0[2], v0[3]); w.z = cvt_pk_bf16(v1[0], v1[1]); w.w = cvt_pk_bf16(v1[2], v1[3]);
                    *(u32x4*)(rowp + bj * HALF) = w; } }
    }
};
}

#define DI __device__ __forceinline__
typedef unsigned short u16;
typedef short bf16x8 __attribute__((ext_vector_type(8)));
typedef short s16x4 __attribute__((ext_vector_type(4)));
typedef float f32x4 __attribute__((ext_vector_type(4)));
typedef float f32x16 __attribute__((ext_vector_type(16)));
typedef unsigned u32x4 __attribute__((ext_vector_type(4)));
typedef unsigned u32x2 __attribute__((ext_vector_type(2)));

constexpr int NLAT = 32768, NCTX = 1024, NTOK = 33792, DM = 1024, NP = 2560, SEQ = 8192, CTXL = 256, SKV = 8448, NIN = 2400;
constexpr int C_CKV = 0, C_KR = 128, C_S5 = 160, C_CQ = 416, C_POOL = 608, C_SU = 864, C_SV = 1120, C_G = 1376;
constexpr float LN_EPS = 1e-6f, ALPHA = 1.4142135623730951f;
constexpr float QSCALE = 0.10206207261596575f * 1.4426950408889634f;
constexpr int KSPLIT = 8;

constexpr size_t OFF_WTIN = 0;
constexpr size_t OFF_WTOUT = OFF_WTIN + (size_t)2 * NP * DM * 2;
constexpr size_t OFF_WTUKV = OFF_WTOUT + (size_t)2 * DM * DM * 2;
constexpr size_t OFF_WTUQ = OFF_WTUKV + (size_t)2 * 512 * 128 * 2;
constexpr size_t OFF_WTGLU = OFF_WTUQ + (size_t)2 * 384 * 192 * 2;
constexpr size_t OFF_WTPOOL = OFF_WTGLU + (size_t)2 * 256 * 256 * 2;
constexpr size_t OFF_WS16 = OFF_WTPOOL + (size_t)2 * 4 * 64 * 64 * 2;
constexpr size_t OFF_MODP = OFF_WS16 + (size_t)2 * 4 * 128 * 128 * 2;
constexpr size_t OFF_LB = OFF_MODP + (size_t)2 * KSPLIT * 5 * 3072 * 4;
constexpr size_t OFF_BBR = OFF_LB + (size_t)4096 * 2 * 4;
constexpr size_t OFF_BBI = OFF_BBR + (size_t)4096 * 16 * 2;
constexpr size_t OFF_CM = OFF_BBI + (size_t)4096 * 16 * 2;
constexpr size_t OFF_ROPE = OFF_CM + (size_t)64 * 16 * 128 * 2;
constexpr size_t OFF_E = OFF_ROPE + (size_t)8192 * 16 * 2 * 4;
constexpr size_t OFF_CTX1 = OFF_E + (size_t)2 * 4 * 66 * 16 * 64 * 2 * 4;
constexpr size_t OFF_H = OFF_CTX1 + (size_t)NCTX * DM * 4;
constexpr size_t OFF_PROJ = OFF_H + (size_t)NTOK * DM * 2;
constexpr size_t OFF_Y = OFF_PROJ + (size_t)NTOK * NP * 2;
constexpr size_t OFF_Q = OFF_Y + (size_t)NTOK * DM * 2;
constexpr size_t OFF_K = OFF_Q + (size_t)16 * SKV * 96 * 2;
constexpr size_t OFF_V = OFF_K + (size_t)16 * SKV * 96 * 2;
constexpr size_t OFF_BAR = OFF_V + (size_t)16 * SKV * 64 * 2;
constexpr size_t OFF_CNT = OFF_BAR + 16384;
constexpr size_t BAR_BYTES = 16384 + 256;
constexpr size_t WS_END = OFF_CNT + 256;

constexpr int LDS_BYTES = 147456;

struct Params {
    const float *x, *c, *ctx, *c_ctx, *w_mod, *b_mod, *w_in, *g_q, *w_uq, *g_kv, *w_ukv, *w_pool, *pool_scale, *lam_re, *lam_im, *log_dt,
        *b_re, *b_im, *c_re, *c_im, *s5_d, *w_glu, *b_glu, *sgu_g, *sgu_b, *w_s, *b_s, *w_out, *ln_g, *ln_b;
    float* out; unsigned char* ws;
};

DI int otid() { int t = threadIdx.x; asm volatile("" : "+v"(t)); return t; }
typedef float f32x2_ __attribute__((ext_vector_type(2)));
typedef __bf16 bf16x2_ __attribute__((ext_vector_type(2)));
DI unsigned cvtpk(float lo, float hi) { const f32x2_ v = {lo, hi}; const bf16x2_ b = __builtin_convertvector(v, bf16x2_); return __builtin_bit_cast(unsigned, b); }
DI float bflo(unsigned w) { return __uint_as_float(w << 16); }
DI float bfhi(unsigned w) { return __uint_as_float(w & 0xffff0000u); }
DI float bf2f(u16 v) { return __uint_as_float(((unsigned)v) << 16); }
DI u16 f2bf(float x) { return (u16)(cvtpk(x, x) & 0xffffu); }
DI int crow(int r, int hi) { return (r & 3) + 8 * (r >> 2) + 4 * hi; }
template <int CTRL> DI float dpp_f(float v) { return __builtin_bit_cast(float, __builtin_amdgcn_update_dpp(0, __builtin_bit_cast(int, v), CTRL, 0xf, 0xf, true)); }
DI float wave_sum(float v) {
    v += dpp_f<0xB1>(v);
    v += dpp_f<0x4E>(v);
    v += dpp_f<0x141>(v);
    v += dpp_f<0x140>(v);
    const int iv = __builtin_bit_cast(int, v);
    const float a = __builtin_bit_cast(float, __builtin_amdgcn_readlane(iv, 0)), b = __builtin_bit_cast(float, __builtin_amdgcn_readlane(iv, 16));
    const float c = __builtin_bit_cast(float, __builtin_amdgcn_readlane(iv, 32)), d = __builtin_bit_cast(float, __builtin_amdgcn_readlane(iv, 48));
    return (a + b) + (c + d);
}
DI float fexp2(float x) { return __builtin_amdgcn_exp2f(x); }
DI float sigmoidf_(float x) { return __builtin_amdgcn_rcpf(1.f + fexp2(-1.4426950408889634f * x)); }
DI float siluf_(float x) { return x * sigmoidf_(x); }
DI float gelu_tanh(float y) { const float u = 0.7978845608028654f * (y + 0.044715f * y * y * y); return y * sigmoidf_(2.f * u); }
#define MFMA32(a, b, c) __builtin_amdgcn_mfma_f32_32x32x16_bf16((a), (b), (c), 0, 0, 0)
#define MFMA16(a, b, c) __builtin_amdgcn_mfma_f32_16x16x32_bf16((a), (b), (c), 0, 0, 0)

DI void sincos_acc(float x, float& s, float& c) {
    const float k = rintf(x * 0.6366197723675814f);
    float r = fmaf(k, -1.5707963705062866f, x);
    r = fmaf(k, 4.371138828673793e-8f, r);
    const int q = ((int)k) & 3;
    const float r2 = r * r;
    const float sp = fmaf(r * r2, fmaf(r2, fmaf(r2, -1.9515295891e-4f, 8.3321608736e-3f), -1.6666654611e-1f), r);
    const float cp = fmaf(r2 * r2, fmaf(r2, fmaf(r2, 2.443315711809948e-5f, -1.388731625493765e-3f), 4.166664568298827e-2f), fmaf(r2, -0.5f, 1.f));
    const float s0 = (q & 1) ? cp : sp, c0 = (q & 1) ? sp : cp;
    s = (q & 2) ? -s0 : s0;
    c = ((q == 1) || (q == 2)) ? -c0 : c0;
}

DI void transpose_tile(const float* __restrict__ src, int C, int r0, int c0, u16* __restrict__ dst, int ldd, float* tile) {
    const int tid = otid();
#pragma unroll
    for (int i = 0; i < 2; ++i) {
        const int r = (tid >> 4) + 32 * i, c = (tid & 15) * 4;
        f32x4 v = {0.f, 0.f, 0.f, 0.f};
        if (c0 + c < C) v = *(const f32x4*)(src + (size_t)(r0 + r) * C + c0 + c);
        tile[r * 65 + c] = v[0]; tile[r * 65 + c + 1] = v[1]; tile[r * 65 + c + 2] = v[2]; tile[r * 65 + c + 3] = v[3];
    }
    __syncthreads();
    const int c = tid >> 3, r8 = (tid & 7) * 8;
    if (c0 + c < C) {
        u32x4 w;
        w.x = cvtpk(tile[(r8 + 0) * 65 + c], tile[(r8 + 1) * 65 + c]); w.y = cvtpk(tile[(r8 + 2) * 65 + c], tile[(r8 + 3) * 65 + c]);
        w.z = cvtpk(tile[(r8 + 4) * 65 + c], tile[(r8 + 5) * 65 + c]); w.w = cvtpk(tile[(r8 + 6) * 65 + c], tile[(r8 + 7) * 65 + c]);
        *(u32x4*)(dst + (size_t)(c0 + c) * ldd + r0 + r8) = w;
    }
    __syncthreads();
}

DI void phase_w(const Params& p, unsigned char* smem) {
    float* tile = (float*)smem;
    const int tid = otid();
    u16* wtin = (u16*)(p.ws + OFF_WTIN); u16* wtout = (u16*)(p.ws + OFF_WTOUT); u16* wtukv = (u16*)(p.ws + OFF_WTUKV); u16* wtuq = (u16*)(p.ws + OFF_WTUQ);
    u16* wtglu = (u16*)(p.ws + OFF_WTGLU); u16* wtpool = (u16*)(p.ws + OFF_WTPOOL); u16* ws16 = (u16*)(p.ws + OFF_WS16);
    constexpr int T_IN = 16 * 38, T_OUT = 256, T_UKV = 16, T_UQ = 18, T_GLU = 16, T_POOL = 4, T_L = T_IN + T_OUT + T_UKV + T_UQ + T_GLU + T_POOL;
    constexpr int U_TR = 2 * T_L, U_PAD = 80, U_WS = 32, U_MOD = 2 * 6 * KSPLIT, U_S5 = 8, U_ROPE = 256;
    constexpr int U_TOT = U_TR + U_PAD + U_WS + U_MOD + U_S5 + U_ROPE;
    for (int u = blockIdx.x; u < U_TOT; u += gridDim.x) {
        int v = u;
        if (v < U_TR) {
            const int l = v / T_L; int t = v % T_L;
            if (t < T_IN) { transpose_tile(p.w_in + (size_t)l * DM * NIN, NIN, (t / 38) * 64, (t % 38) * 64, wtin + (size_t)l * NP * DM, DM, tile); continue; }
            t -= T_IN;
            if (t < T_OUT) { transpose_tile(p.w_out + (size_t)l * DM * DM, DM, (t / 16) * 64, (t % 16) * 64, wtout + (size_t)l * DM * DM, DM, tile); continue; }
            t -= T_OUT;
            if (t < T_UKV) { transpose_tile(p.w_ukv + (size_t)l * 128 * 512, 512, (t / 8) * 64, (t % 8) * 64, wtukv + (size_t)l * 512 * 128, 128, tile); continue; }
            t -= T_UKV;
            if (t < T_UQ) { transpose_tile(p.w_uq + (size_t)l * 192 * 384, 384, (t / 6) * 64, (t % 6) * 64, wtuq + (size_t)l * 384 * 192, 192, tile); continue; }
            t -= T_UQ;
            if (t < T_GLU) { transpose_tile(p.w_glu + (size_t)l * 256 * 256, 256, (t / 4) * 64, (t % 4) * 64, wtglu + (size_t)l * 256 * 256, 256, tile); continue; }
            t -= T_GLU;
            transpose_tile(p.w_pool + (size_t)(l * 4 + t) * 64 * 64, 64, 0, 0, wtpool + (size_t)(l * 4 + t) * 64 * 64, 64, tile);
            continue;
        }
        v -= U_TR;
        if (v < U_PAD) {
            const int e = (v * 512 + tid) * 8; const int l = e / (160 * 1024), o = e % (160 * 1024);
            *(u32x4*)(wtin + (size_t)l * NP * DM + (size_t)NIN * DM + o) = (u32x4){0u, 0u, 0u, 0u};
            continue;
        }
        v -= U_PAD;
        if (v < U_WS) {
            const int e = (v * 512 + tid) * 8;
            const f32x4 a = *(const f32x4*)(p.w_s + e), b = *(const f32x4*)(p.w_s + e + 4);
            u32x4 w; w.x = cvtpk(a[0], a[1]); w.y = cvtpk(a[2], a[3]); w.z = cvtpk(b[0], b[1]); w.w = cvtpk(b[2], b[3]);
            *(u32x4*)(ws16 + e) = w;
            continue;
        }
        v -= U_WS;
        if (v < U_MOD) {
            const int l = v / (6 * KSPLIT), chunk = (v / KSPLIT) % 6, ks = v % KSPLIT;
            constexpr int KL = DM / KSPLIT;
            float* sv = (float*)smem;
            for (int i = tid; i < 5 * KL; i += 512) { const int j = i / KL, kk = i % KL; const float a = (j < 4) ? p.c[j * DM + ks * KL + kk] : p.c_ctx[ks * KL + kk]; sv[i] = siluf_(a); }
            __syncthreads();
            const int n = chunk * 512 + tid;
            const float* wp = p.w_mod + (size_t)l * DM * 3072 + (size_t)(ks * KL) * 3072 + n;
            float a0 = 0.f, a1 = 0.f, a2 = 0.f, a3 = 0.f, a4 = 0.f;
#pragma unroll 8
            for (int kk = 0; kk < KL; ++kk) { const float w = wp[(size_t)kk * 3072]; a0 = fmaf(sv[kk], w, a0); a1 = fmaf(sv[KL + kk], w, a1); a2 = fmaf(sv[2 * KL + kk], w, a2); a3 = fmaf(sv[3 * KL + kk], w, a3); a4 = fmaf(sv[4 * KL + kk], w, a4); }
            float* mp = (float*)(p.ws + OFF_MODP) + (size_t)((l * KSPLIT + ks) * 5) * 3072 + n;
            mp[0] = a0; mp[3072] = a1; mp[2 * 3072] = a2; mp[3 * 3072] = a3; mp[4 * 3072] = a4;
            __syncthreads();
            continue;
        }
        v -= U_MOD;
        if (v < U_S5) {
            const int idx = v * 512 + tid;
            const float lr = p.lam_re[idx], li = p.lam_im[idx], dt = expf(p.log_dt[idx >> 6]);
            const float mag = expf(lr * dt); float sn, cs; sincos_acc(li * dt, sn, cs);
            const float lbr = mag * cs, lbi = mag * sn, nr = lbr - 1.f, ni = lbi, den = lr * lr + li * li;
            const float kr = (nr * lr + ni * li) / den, ki = (ni * lr - nr * li) / den;
            float* lb = (float*)(p.ws + OFF_LB); lb[idx * 2] = lbr; lb[idx * 2 + 1] = lbi;
            u16* bbr = (u16*)(p.ws + OFF_BBR) + (size_t)idx * 16; u16* bbi = (u16*)(p.ws + OFF_BBI) + (size_t)idx * 16;
            u16* cm = (u16*)(p.ws + OFF_CM);
            const int pp = idx & 63;
            for (int h = 0; h < 16; ++h) {
                const float br = p.b_re[(size_t)idx * 16 + h], bi = p.b_im[(size_t)idx * 16 + h];
                bbr[h] = f2bf(kr * br - ki * bi); bbi[h] = f2bf(kr * bi + ki * br);
                const size_t ci = ((size_t)(idx >> 6) * 16 + h) * 64 + pp;
                *(unsigned*)(cm + ((size_t)(idx >> 6) * 16 + h) * 128 + 2 * pp) = cvtpk(p.c_re[ci], -p.c_im[ci]);
            }
            continue;
        }
        v -= U_S5;
        {
            const int it = v * 512 + tid; const int t = it >> 4, a = (it >> 3) & 1, f = it & 7;
            const float pos = (float)(a ? (t & 63) : (t >> 6));
            const float inv = exp2f(-(float)f * 0.125f * 13.287712379549449f);
            float sn, cs; sincos_acc(pos * inv, sn, cs);
            float* rp = (float*)(p.ws + OFF_ROPE) + (size_t)it * 2; rp[0] = cs; rp[1] = sn;
        }
    }
}

DI void load_mod(const Params& p, int l, int j, int which, float* dst) {
    const float* mp = (const float*)(p.ws + OFF_MODP);
    for (int c = otid(); c < DM; c += 512) {
        float v = p.b_mod[l * 3072 + which * DM + c];
#pragma unroll
        for (int ks = 0; ks < KSPLIT; ++ks) v += mp[(size_t)((l * KSPLIT + ks) * 5 + j) * 3072 + which * DM + c];
        dst[c] = v;
    }
}

DI void phase_a(const Params& p, unsigned char* smem) {
    float* shift = (float*)smem; float* scale = shift + DM;
    u16* hb = (u16*)(p.ws + OFF_H);
    const int tid = otid(), wid = __builtin_amdgcn_readfirstlane(tid >> 6), lane = tid & 63;
    for (int u = blockIdx.x; u < 512; u += gridDim.x) {
        const bool cx = u >= 256; const int r0 = cx ? NLAT + (u - 256) * 4 : u * 128; const int j = cx ? 4 : (r0 >> 13);
        const int rpw = cx ? 1 : 16;
        __syncthreads();
        load_mod(p, 0, j, 0, shift); load_mod(p, 0, j, 1, scale);
        __syncthreads();
        if (cx && wid >= 4) continue;
        const int rowb = r0 + wid * rpw;
        const float* xb_ = (rowb < NLAT) ? p.x + (size_t)rowb * DM : p.ctx + (size_t)(rowb - NLAT) * DM;
        f32x4 nx[4];
#pragma unroll
        for (int i = 0; i < 4; ++i) nx[i] = __builtin_nontemporal_load((const f32x4*)(xb_ + i * 256 + lane * 4));
        f32x4 sc4[4], sh4[4];
#pragma unroll
        for (int i = 0; i < 4; ++i) { sc4[i] = *(const f32x4*)(scale + i * 256 + lane * 4); sh4[i] = *(const f32x4*)(shift + i * 256 + lane * 4); }
        for (int rr = 0; rr < rpw; ++rr) {
            const int row = rowb + rr;
            f32x4 v[4]; float s = 0.f;
#pragma unroll
            for (int i = 0; i < 4; ++i) { v[i] = nx[i]; s += v[i][0] + v[i][1] + v[i][2] + v[i][3]; }
            if (rr + 1 < rpw) {
#pragma unroll
                for (int i = 0; i < 4; ++i) nx[i] = __builtin_nontemporal_load((const f32x4*)(xb_ + (size_t)(rr + 1) * DM + i * 256 + lane * 4));
            }
            const float mean = wave_sum(s) * (1.f / DM);
            float q = 0.f;
#pragma unroll
            for (int i = 0; i < 4; ++i)
#pragma unroll
                for (int k = 0; k < 4; ++k) { const float d = v[i][k] - mean; q += d * d; }
            const float rstd = rsqrtf(wave_sum(q) * (1.f / DM) + LN_EPS);
#pragma unroll
            for (int i = 0; i < 4; ++i) {
                const int c = i * 256 + lane * 4; float o[4];
#pragma unroll
                for (int k = 0; k < 4; ++k) o[k] = (v[i][k] - mean) * rstd * (1.f + sc4[i][k]) + sh4[i][k];
                u32x2 w; w.x = cvtpk(o[0], o[1]); w.y = cvtpk(o[2], o[3]);
                *(u32x2*)(hb + (size_t)row * DM + c) = w;
            }
        }
    }
}

#ifndef S5_OUT_SCALE
#define S5_OUT_SCALE 1.f
#endif
#ifndef SGU_OUT_SCALE
#define SGU_OUT_SCALE 1.f
#endif
#ifndef POOL_OUT_SCALE
#define POOL_OUT_SCALE 1.f
#endif
#ifndef Y_SCALE
#define Y_SCALE 1.f
#endif
DI void phase_f(const Params& p, int l, unsigned char* smem) {
    float* gate = (float*)smem; float* shift = gate + DM; float* scale = shift + DM;
    const u16* yb = (const u16*)(p.ws + OFF_Y);
    u16* hb = (u16*)(p.ws + OFF_H);
    float* ctx1 = (float*)(p.ws + OFF_CTX1);
    const int tid = otid(), wid = __builtin_amdgcn_readfirstlane(tid >> 6), lane = tid & 63;
    const float* lg = p.ln_g + l * DM; const float* lbv = p.ln_b + l * DM;
    for (int u = blockIdx.x; u < (l ? 256 : 512); u += gridDim.x) {
        const bool cx = u >= 256; const int r0 = cx ? NLAT + (u - 256) * 4 : u * 128; const int j = cx ? 4 : (r0 >> 13);
        const int rpw = cx ? 1 : 16;
        __syncthreads();
        load_mod(p, l, j, 2, gate);
        if (l == 0) { load_mod(p, 1, j, 0, shift); load_mod(p, 1, j, 1, scale); }
        __syncthreads();
        if (cx && wid >= 4) continue;
        const int rowb = r0 + wid * rpw;
        const float* xb_; float* ob_;
        if (l == 0) { xb_ = (rowb < NLAT) ? p.x + (size_t)rowb * DM : p.ctx + (size_t)(rowb - NLAT) * DM; ob_ = (rowb < NLAT) ? p.out + (size_t)rowb * DM : ctx1 + (size_t)(rowb - NLAT) * DM; }
        else { xb_ = p.out + (size_t)rowb * DM; ob_ = p.out + (size_t)rowb * DM; }
        f32x4 nx[4]; u32x2 ny[4];
#pragma unroll
        for (int i = 0; i < 4; ++i) { nx[i] = __builtin_nontemporal_load((const f32x4*)(xb_ + i * 256 + lane * 4)); ny[i] = *(const u32x2*)(yb + (size_t)rowb * DM + i * 256 + lane * 4); }
        f32x4 gt4[4], g4r[4], b4r[4], sc4[4], sh4[4];
#pragma unroll
        for (int i = 0; i < 4; ++i) {
            const int c = i * 256 + lane * 4;
            gt4[i] = *(const f32x4*)(gate + c); g4r[i] = *(const f32x4*)(lg + c); b4r[i] = *(const f32x4*)(lbv + c);
            if (l == 0) { sc4[i] = *(const f32x4*)(scale + c); sh4[i] = *(const f32x4*)(shift + c); }
        }
        for (int rr = 0; rr < rpw; ++rr) {
            const int row = rowb + rr;
            float* op = ob_ + (size_t)rr * DM;
            f32x4 v[4]; float s = 0.f;
            f32x4 cx[4]; u32x2 cy[4];
#pragma unroll
            for (int i = 0; i < 4; ++i) { cx[i] = nx[i]; cy[i] = ny[i]; }
            if (rr + 1 < rpw) {
#pragma unroll
                for (int i = 0; i < 4; ++i) { nx[i] = __builtin_nontemporal_load((const f32x4*)(xb_ + (size_t)(rr + 1) * DM + i * 256 + lane * 4)); ny[i] = *(const u32x2*)(yb + (size_t)(row + 1) * DM + i * 256 + lane * 4); }
            }
#pragma unroll
            for (int i = 0; i < 4; ++i) {
                const int c = i * 256 + lane * 4;
                const f32x4 xv = cx[i]; const u32x2 yw = cy[i];
                v[i][0] = ALPHA * xv[0] + Y_SCALE * gt4[i][0] * bflo(yw.x); v[i][1] = ALPHA * xv[1] + Y_SCALE * gt4[i][1] * bfhi(yw.x);
                v[i][2] = ALPHA * xv[2] + Y_SCALE * gt4[i][2] * bflo(yw.y); v[i][3] = ALPHA * xv[3] + Y_SCALE * gt4[i][3] * bfhi(yw.y);
                s += v[i][0] + v[i][1] + v[i][2] + v[i][3];
            }
            const float mean = wave_sum(s) * (1.f / DM);
            float q = 0.f;
#pragma unroll
            for (int i = 0; i < 4; ++i)
#pragma unroll
                for (int k = 0; k < 4; ++k) { const float d = v[i][k] - mean; q += d * d; }
            const float rstd = rsqrtf(wave_sum(q) * (1.f / DM) + LN_EPS);
            float s2 = 0.f;
#pragma unroll
            for (int i = 0; i < 4; ++i) {
                const int c = i * 256 + lane * 4;
#pragma unroll
                for (int k = 0; k < 4; ++k) { v[i][k] = (v[i][k] - mean) * rstd * g4r[i][k] + b4r[i][k]; s2 += v[i][k]; }
                __builtin_nontemporal_store(v[i], (f32x4*)(op + c));
            }
            if (l == 0) {
                const float m2 = wave_sum(s2) * (1.f / DM);
                float q2 = 0.f;
#pragma unroll
                for (int i = 0; i < 4; ++i)
#pragma unroll
                    for (int k = 0; k < 4; ++k) { const float d = v[i][k] - m2; q2 += d * d; }
                const float rs2 = rsqrtf(wave_sum(q2) * (1.f / DM) + LN_EPS);
#pragma unroll
                for (int i = 0; i < 4; ++i) {
                    const int c = i * 256 + lane * 4; float o[4];
#pragma unroll
                    for (int k = 0; k < 4; ++k) o[k] = (v[i][k] - m2) * rs2 * (1.f + sc4[i][k]) + sh4[i][k];
                    u32x2 w; w.x = cvtpk(o[0], o[1]); w.y = cvtpk(o[2], o[3]);
                    *(u32x2*)(hb + (size_t)row * DM + c) = w;
                }
            }
        }
    }
}

DI void phase_gemm(const u16* A, const u16* Bt, u16* O, int M, int N, int ldc, unsigned char* smem) {
    pg8::Gemm g; g.A = A; g.Bt = Bt; g.M = M; g.N = N; g.K = DM;
    pg8::StaticOrder S; S.init(M, N, (int)gridDim.x, (int)blockIdx.x);
    pg8::EpiStoreBf16 E; E.O = O; E.ldc = ldc;
    pg8::gemm_phase<pg8::EpiStoreBf16, pg8::StaticOrder, false>((PG8_LAS unsigned char*)smem, g, S, E, nullptr);
}

struct OneUnitOrder {
    int pm, pn;
    __device__ __forceinline__ bool next(int i, pg8::Unit& u) const { if (i != 0) return false; u.pm = pm; u.pn = pn; return true; }
    __device__ __forceinline__ void a_ready(const pg8::Unit&) const {}
    __device__ __forceinline__ void done(const pg8::Unit&) const {}
};
DI void unit_gemm_one(const u16* A, const u16* Bt, u16* O, int N, int pm, int pn, unsigned char* smem) {
    pg8::Gemm g; g.A = A; g.Bt = Bt; g.M = NTOK; g.N = N; g.K = DM;
    OneUnitOrder S; S.pm = pm; S.pn = pn;
    pg8::EpiStoreBf16 E; E.O = O; E.ldc = N;
    __syncthreads();
    pg8::gemm_phase<pg8::EpiStoreBf16, OneUnitOrder, false>((PG8_LAS unsigned char*)smem, g, S, E, nullptr);
}
DI void publish_unit(unsigned* cnt) {
    asm volatile("s_waitcnt vmcnt(0)" ::: "memory");
    __syncthreads();
    if (threadIdx.x == 0) { __threadfence(); __hip_atomic_fetch_add(cnt, 1u, __ATOMIC_RELEASE, __HIP_MEMORY_SCOPE_AGENT); }
}
DI void wait_units(const unsigned* cnt, unsigned need) {
    if (threadIdx.x == 0) { while (__hip_atomic_load(cnt, __ATOMIC_RELAXED, __HIP_MEMORY_SCOPE_AGENT) < need) __builtin_amdgcn_s_sleep(8); }
    __syncthreads();
}
DI void unit_gemm_ctx(const Params& p, int l, int i, unsigned char* smem, unsigned* done_cnt) {
    const int npn = l ? 2 : 10;
    pg8::Gemm g; g.A = (const u16*)(p.ws + OFF_H); g.Bt = (const u16*)(p.ws + OFF_WTIN) + (size_t)l * NP * DM; g.M = NTOK; g.N = NP; g.K = DM;
    OneUnitOrder S; S.pm = 128 + i / npn; S.pn = i % npn;
    pg8::EpiStoreBf16 E; E.O = (u16*)(p.ws + OFF_PROJ); E.ldc = NP;
    __syncthreads();
    pg8::gemm_phase<pg8::EpiStoreBf16, OneUnitOrder, false>((PG8_LAS unsigned char*)smem, g, S, E, nullptr);
    asm volatile("s_waitcnt vmcnt(0)" ::: "memory");
    __syncthreads();
    if (threadIdx.x == 0) { __threadfence(); __hip_atomic_fetch_add(done_cnt, 1u, __ATOMIC_RELEASE, __HIP_MEMORY_SCOPE_AGENT); }
}

DI void row_info(int r, int& b, int& t, int& isctx) { if (r < NLAT) { b = r >> 13; t = r & 8191; isctx = 0; } else { const int rc = r - NLAT; b = rc >> 8; t = rc & 255; isctx = 1; } }

DI void unit_mla(const Params& p, int l, int u, unsigned char* smem) {
    const int tid = otid(), wid = __builtin_amdgcn_readfirstlane(tid >> 6), lane = tid & 63, r32 = lane & 31, hi = lane >> 5;
    const u16* proj = (const u16*)(p.ws + OFF_PROJ);
    u16* Qg = (u16*)(p.ws + OFF_Q); u16* Kg = (u16*)(p.ws + OFF_K); u16* Vg = (u16*)(p.ws + OFF_V);
    const float* rope = (const float*)(p.ws + OFF_ROPE);
    u16* Akv = (u16*)smem;
    u16* Aq = (u16*)(smem + 64 * 272);
    const int r0 = u * 64; int b, t0, isctx; row_info(r0, b, t0, isctx);
    const int s0 = isctx ? t0 : 256 + t0;
    __syncthreads();
    {
        const int m = tid >> 3, q = tid & 7; const u16* pr = proj + (size_t)(r0 + m) * NP;
        u32x4 kv[2], cq[3], krv = {0u, 0u, 0u, 0u};
#pragma unroll
        for (int i = 0; i < 2; ++i) kv[i] = *(const u32x4*)(pr + C_CKV + q * 16 + i * 8);
#pragma unroll
        for (int i = 0; i < 3; ++i) cq[i] = *(const u32x4*)(pr + C_CQ + q * 24 + i * 8);
        if (q < 4) krv = *(const u32x4*)(pr + C_KR + q * 8);
        f32x4 gk[4], gq[6];
#pragma unroll
        for (int i = 0; i < 4; ++i) gk[i] = *(const f32x4*)(p.g_kv + l * 128 + q * 16 + i * 4);
#pragma unroll
        for (int i = 0; i < 6; ++i) gq[i] = *(const f32x4*)(p.g_q + l * 192 + q * 24 + i * 4);
        float cs[8], sn[8];
        if (q < 4 && !isctx) {
            const float* rp = rope + ((size_t)(t0 + m) * 16 + (q >> 1) * 8) * 2;
#pragma unroll
            for (int i = 0; i < 4; ++i) { const f32x4 v = *(const f32x4*)(rp + i * 4); cs[2 * i] = v[0]; sn[2 * i] = v[1]; cs[2 * i + 1] = v[2]; sn[2 * i + 1] = v[3]; }
        } else {
#pragma unroll
            for (int i = 0; i < 8; ++i) { cs[i] = 1.f; sn[i] = 0.f; }
        }
        { float x[16]; float ss = 0.f;
#pragma unroll
          for (int i = 0; i < 2; ++i) { x[8 * i] = bflo(kv[i].x); x[8 * i + 1] = bfhi(kv[i].x); x[8 * i + 2] = bflo(kv[i].y); x[8 * i + 3] = bfhi(kv[i].y);
              x[8 * i + 4] = bflo(kv[i].z); x[8 * i + 5] = bfhi(kv[i].z); x[8 * i + 6] = bflo(kv[i].w); x[8 * i + 7] = bfhi(kv[i].w); }
#pragma unroll
          for (int i = 0; i < 16; ++i) ss += x[i] * x[i];
          ss += dpp_f<0xB1>(ss); ss += dpp_f<0x4E>(ss); ss += dpp_f<0x141>(ss);
          const float rs = rsqrtf(ss * (1.f / 128.f) + LN_EPS);
#pragma unroll
          for (int i = 0; i < 2; ++i) { u32x4 w;
              w.x = cvtpk(x[8 * i] * rs * gk[2 * i][0], x[8 * i + 1] * rs * gk[2 * i][1]); w.y = cvtpk(x[8 * i + 2] * rs * gk[2 * i][2], x[8 * i + 3] * rs * gk[2 * i][3]);
              w.z = cvtpk(x[8 * i + 4] * rs * gk[2 * i + 1][0], x[8 * i + 5] * rs * gk[2 * i + 1][1]); w.w = cvtpk(x[8 * i + 6] * rs * gk[2 * i + 1][2], x[8 * i + 7] * rs * gk[2 * i + 1][3]);
              *(u32x4*)(Akv + m * 136 + q * 16 + i * 8) = w; } }
        { float x[24]; float ss = 0.f;
#pragma unroll
          for (int i = 0; i < 3; ++i) { x[8 * i] = bflo(cq[i].x); x[8 * i + 1] = bfhi(cq[i].x); x[8 * i + 2] = bflo(cq[i].y); x[8 * i + 3] = bfhi(cq[i].y);
              x[8 * i + 4] = bflo(cq[i].z); x[8 * i + 5] = bfhi(cq[i].z); x[8 * i + 6] = bflo(cq[i].w); x[8 * i + 7] = bfhi(cq[i].w); }
#pragma unroll
          for (int i = 0; i < 24; ++i) ss += x[i] * x[i];
          ss += dpp_f<0xB1>(ss); ss += dpp_f<0x4E>(ss); ss += dpp_f<0x141>(ss);
          const float rs = rsqrtf(ss * (1.f / 192.f) + LN_EPS);
#pragma unroll
          for (int i = 0; i < 3; ++i) { u32x4 w;
              w.x = cvtpk(x[8 * i] * rs * gq[2 * i][0], x[8 * i + 1] * rs * gq[2 * i][1]); w.y = cvtpk(x[8 * i + 2] * rs * gq[2 * i][2], x[8 * i + 3] * rs * gq[2 * i][3]);
              w.z = cvtpk(x[8 * i + 4] * rs * gq[2 * i + 1][0], x[8 * i + 5] * rs * gq[2 * i + 1][1]); w.w = cvtpk(x[8 * i + 6] * rs * gq[2 * i + 1][2], x[8 * i + 7] * rs * gq[2 * i + 1][3]);
              *(u32x4*)(Aq + m * 200 + q * 24 + i * 8) = w; } }
        { u32x4 pw;
          pw.x = (unsigned)__builtin_amdgcn_update_dpp(0, (int)krv.x, 0xB1, 0xf, 0xf, true); pw.y = (unsigned)__builtin_amdgcn_update_dpp(0, (int)krv.y, 0xB1, 0xf, 0xf, true);
          pw.z = (unsigned)__builtin_amdgcn_update_dpp(0, (int)krv.z, 0xB1, 0xf, 0xf, true); pw.w = (unsigned)__builtin_amdgcn_update_dpp(0, (int)krv.w, 0xB1, 0xf, 0xf, true);
          if (q < 4) {
              const float sg = (q & 1) ? 1.f : -1.f;
              float me[8], ot[8];
              me[0] = bflo(krv.x); me[1] = bfhi(krv.x); me[2] = bflo(krv.y); me[3] = bfhi(krv.y); me[4] = bflo(krv.z); me[5] = bfhi(krv.z); me[6] = bflo(krv.w); me[7] = bfhi(krv.w);
              ot[0] = bflo(pw.x); ot[1] = bfhi(pw.x); ot[2] = bflo(pw.y); ot[3] = bfhi(pw.y); ot[4] = bflo(pw.z); ot[5] = bfhi(pw.z); ot[6] = bflo(pw.w); ot[7] = bfhi(pw.w);
              float o[8];
#pragma unroll
              for (int i = 0; i < 8; ++i) o[i] = me[i] * cs[i] + sg * ot[i] * sn[i];
              u32x4 w; w.x = cvtpk(o[0], o[1]); w.y = cvtpk(o[2], o[3]); w.z = cvtpk(o[4], o[5]); w.w = cvtpk(o[6], o[7]);
#pragma unroll
              for (int h = 0; h < 4; ++h) *(u32x4*)(Kg + ((size_t)(b * 4 + h) * SKV + s0 + m) * 96 + 64 + q * 8) = w;
          } }
    }
    __syncthreads();
    {
        const int h = wid >> 1, part = wid & 1, n0 = h * 128 + part * 64;
        const u16* W = (const u16*)(p.ws + OFF_WTUKV) + (size_t)l * 512 * 128;
        f32x16 acc[2][2];
#pragma unroll
        for (int i = 0; i < 2; ++i)
#pragma unroll
            for (int j = 0; j < 2; ++j)
#pragma unroll
                for (int r = 0; r < 16; ++r) acc[i][j][r] = 0.f;
#pragma unroll
        for (int ks = 0; ks < 8; ++ks) {
            bf16x8 af[2], bf[2];
#pragma unroll
            for (int i = 0; i < 2; ++i) af[i] = *(const bf16x8*)(Akv + (i * 32 + r32) * 136 + ks * 16 + hi * 8);
#pragma unroll
            for (int j = 0; j < 2; ++j) bf[j] = *(const bf16x8*)(W + (size_t)(n0 + j * 32 + r32) * 128 + ks * 16 + hi * 8);
#pragma unroll
            for (int i = 0; i < 2; ++i)
#pragma unroll
                for (int j = 0; j < 2; ++j) acc[i][j] = MFMA32(bf[j], af[i], acc[i][j]);
        }
        u16* dst = part ? Vg : Kg; const int ld = part ? 64 : 96;
#pragma unroll
        for (int i = 0; i < 2; ++i)
#pragma unroll
            for (int j = 0; j < 2; ++j)
#pragma unroll
                for (int r4 = 0; r4 < 4; ++r4) {
                    u32x2 w; w.x = cvtpk(acc[i][j][4 * r4], acc[i][j][4 * r4 + 1]); w.y = cvtpk(acc[i][j][4 * r4 + 2], acc[i][j][4 * r4 + 3]);
                    *(u32x2*)(dst + ((size_t)(b * 4 + h) * SKV + s0 + i * 32 + r32) * ld + j * 32 + 8 * r4 + 4 * hi) = w;
                }
    }
    for (int blk = wid; blk < 12; blk += 8) {
        const int h = blk / 3, part = blk % 3, n0 = blk * 32;
        const u16* W = (const u16*)(p.ws + OFF_WTUQ) + (size_t)l * 384 * 192;
        f32x16 acc[2];
#pragma unroll
        for (int i = 0; i < 2; ++i)
#pragma unroll
            for (int r = 0; r < 16; ++r) acc[i][r] = 0.f;
#pragma unroll
        for (int ks = 0; ks < 12; ++ks) {
            const bf16x8 bfr = *(const bf16x8*)(W + (size_t)(n0 + r32) * 192 + ks * 16 + hi * 8);
#pragma unroll
            for (int i = 0; i < 2; ++i) { const bf16x8 af = *(const bf16x8*)(Aq + (i * 32 + r32) * 200 + ks * 16 + hi * 8); acc[i] = MFMA32(bfr, af, acc[i]); }
        }
#pragma unroll
        for (int i = 0; i < 2; ++i) {
            const int m = i * 32 + r32;
            if (part == 2 && !isctx) {
                const float* rp = rope + ((size_t)(t0 + m) * 16 + 4 * hi) * 2;
#pragma unroll
                for (int a = 0; a < 2; ++a) {
                    const f32x4 cs0 = *(const f32x4*)(rp + a * 16), cs1 = *(const f32x4*)(rp + a * 16 + 4);
                    const float cc[4] = {cs0[0], cs0[2], cs1[0], cs1[2]}, ss[4] = {cs0[1], cs0[3], cs1[1], cs1[3]};
#pragma unroll
                    for (int k = 0; k < 4; ++k) { const float x1 = acc[i][8 * a + k], x2 = acc[i][8 * a + 4 + k];
                        acc[i][8 * a + k] = x1 * cc[k] - x2 * ss[k]; acc[i][8 * a + 4 + k] = x2 * cc[k] + x1 * ss[k]; }
                }
            }
#pragma unroll
            for (int r4 = 0; r4 < 4; ++r4) {
                u32x2 w; w.x = cvtpk(acc[i][4 * r4] * QSCALE, acc[i][4 * r4 + 1] * QSCALE); w.y = cvtpk(acc[i][4 * r4 + 2] * QSCALE, acc[i][4 * r4 + 3] * QSCALE);
                *(u32x2*)(Qg + ((size_t)(b * 4 + h) * SKV + s0 + m) * 96 + part * 32 + 8 * r4 + 4 * hi) = w;
            }
        }
    }
}

DI void unit_sgu(const Params& p, int l, int u, unsigned char* smem) {
    const int tid = otid(), wid = __builtin_amdgcn_readfirstlane(tid >> 6), lane = tid & 63, r32 = lane & 31, hi = lane >> 5;
    const u16* proj = (const u16*)(p.ws + OFF_PROJ); u16* mix = (u16*)(p.ws + OFF_H);
    u16* vnT = (u16*)smem;
    const int r0 = u * 128;
    __syncthreads();
    {
        const int s = tid >> 2, q = tid & 3; const u16* pr = proj + (size_t)(r0 + s) * NP + C_SV + q * 64;
        float xv[64]; float sum = 0.f;
#pragma unroll
        for (int i = 0; i < 8; ++i) { const u32x4 w = *(const u32x4*)(pr + i * 8);
            xv[i * 8 + 0] = bflo(w.x); xv[i * 8 + 1] = bfhi(w.x); xv[i * 8 + 2] = bflo(w.y); xv[i * 8 + 3] = bfhi(w.y);
            xv[i * 8 + 4] = bflo(w.z); xv[i * 8 + 5] = bfhi(w.z); xv[i * 8 + 6] = bflo(w.w); xv[i * 8 + 7] = bfhi(w.w); }
#pragma unroll
        for (int i = 0; i < 64; ++i) sum += xv[i];
        sum += __shfl_xor(sum, 1); sum += __shfl_xor(sum, 2);
        const float mean = sum * (1.f / 256.f);
        float qq = 0.f;
#pragma unroll
        for (int i = 0; i < 64; ++i) { const float d = xv[i] - mean; qq += d * d; }
        qq += __shfl_xor(qq, 1); qq += __shfl_xor(qq, 2);
        const float rstd = rsqrtf(qq * (1.f / 256.f) + LN_EPS);
        const float* gg = p.sgu_g + l * 256 + q * 64; const float* bb = p.sgu_b + l * 256 + q * 64;
#pragma unroll
        for (int i = 0; i < 64; ++i) vnT[(q * 64 + i) * 136 + s] = f2bf((xv[i] - mean) * rstd * gg[i] + bb[i]);
    }
    __syncthreads();
    {
        const int h = wid >> 1, c0 = h * 64 + (wid & 1) * 32;
        const u16* W = (const u16*)(p.ws + OFF_WS16) + (size_t)(l * 4 + h) * 128 * 128;
        f32x16 acc[4];
#pragma unroll
        for (int i = 0; i < 4; ++i)
#pragma unroll
            for (int r = 0; r < 16; ++r) acc[i][r] = 0.f;
        bf16x8 afr[4][8];
#pragma unroll
        for (int i = 0; i < 4; ++i)
#pragma unroll
            for (int ks = 0; ks < 8; ++ks) afr[i][ks] = *(const bf16x8*)(W + (size_t)(i * 32 + r32) * 128 + ks * 16 + hi * 8);
#pragma unroll
        for (int ks = 0; ks < 8; ++ks) {
            const bf16x8 bfr = *(const bf16x8*)(vnT + (c0 + r32) * 136 + ks * 16 + hi * 8);
#pragma unroll
            for (int i = 0; i < 4; ++i) acc[i] = MFMA32(bfr, afr[i][ks], acc[i]);
        }
#pragma unroll
        for (int i = 0; i < 4; ++i) {
            const int t = i * 32 + r32; const size_t row = (size_t)(r0 + t);
            const float bs = p.b_s[(l * 4 + h) * 128 + t];
#pragma unroll
            for (int r4 = 0; r4 < 4; ++r4) {
                const int c = c0 + 8 * r4 + 4 * hi;
                const u32x2 uw = *(const u32x2*)(proj + row * NP + C_SU + c), gw = *(const u32x2*)(proj + row * NP + C_G + 768 + c);
                const float o0 = bflo(uw.x) * (acc[i][4 * r4] + bs) * siluf_(bflo(gw.x)), o1 = bfhi(uw.x) * (acc[i][4 * r4 + 1] + bs) * siluf_(bfhi(gw.x));
                const float o2 = bflo(uw.y) * (acc[i][4 * r4 + 2] + bs) * siluf_(bflo(gw.y)), o3 = bfhi(uw.y) * (acc[i][4 * r4 + 3] + bs) * siluf_(bfhi(gw.y));
                u32x2 w; w.x = cvtpk(SGU_OUT_SCALE * o0, SGU_OUT_SCALE * o1); w.y = cvtpk(SGU_OUT_SCALE * o2, SGU_OUT_SCALE * o3);
                *(u32x2*)(mix + row * DM + 768 + c) = w;
            }
        }
    }
}

DI void unit_pool(const Params& p, int l, int u, unsigned char* smem) {
    const int tid = otid(), wid = __builtin_amdgcn_readfirstlane(tid >> 6), lane = tid & 63, r32 = lane & 31, hi = lane >> 5;
    const u16* proj = (const u16*)(p.ws + OFF_PROJ); u16* mix = (u16*)(p.ws + OFF_H);
    u16* halo = (u16*)smem;
    u16* At = (u16*)(smem + 80 * 512);
    const int r0 = u * 64; int b, t0, isctx; row_info(r0, b, t0, isctx);
    const int n = isctx ? CTXL : SEQ; const int rbase = r0 - t0;
    __syncthreads();
    for (int i = tid; i < 80 * 32; i += 512) {
        const int hr = i >> 5, ch = i & 31; const int t = t0 - 8 + hr;
        if (t >= 0 && t < n) *(u32x4*)(halo + hr * 256 + ch * 8) = *(const u32x4*)(proj + (size_t)(rbase + t) * NP + C_POOL + ch * 8);
    }
    __syncthreads();
    for (int it = tid; it < 64 * 32; it += 512) {
        const int m = it >> 5, cg = it & 31, gi = cg >> 3, w = 2 << gi; const int t = t0 + m;
        const int lo = max(t - (w >> 1), 0), hiw = min(t + w - (w >> 1), n);
        float s[8];
#pragma unroll
        for (int k = 0; k < 8; ++k) s[k] = 0.f;
        for (int tt = lo; tt < hiw; ++tt) {
            const u32x4 v = *(const u32x4*)(halo + (tt - t0 + 8) * 256 + cg * 8);
            s[0] += bflo(v.x); s[1] += bfhi(v.x); s[2] += bflo(v.y); s[3] += bfhi(v.y); s[4] += bflo(v.z); s[5] += bfhi(v.z); s[6] += bflo(v.w); s[7] += bfhi(v.w);
        }
        const float inv = 1.f / (float)(hiw - lo);
        const u32x4 c = *(const u32x4*)(halo + (m + 8) * 256 + cg * 8);
        u32x4 o;
        o.x = cvtpk(s[0] * inv - bflo(c.x), s[1] * inv - bfhi(c.x)); o.y = cvtpk(s[2] * inv - bflo(c.y), s[3] * inv - bfhi(c.y));
        o.z = cvtpk(s[4] * inv - bflo(c.z), s[5] * inv - bfhi(c.z)); o.w = cvtpk(s[6] * inv - bflo(c.w), s[7] * inv - bfhi(c.w));
        *(u32x4*)(At + m * 264 + cg * 8) = o;
    }
    __syncthreads();
    {
        const int gi = wid >> 1, d0 = (wid & 1) * 32;
        const u16* W = (const u16*)(p.ws + OFF_WTPOOL) + (size_t)(l * 4 + gi) * 64 * 64;
        f32x16 acc[2];
#pragma unroll
        for (int i = 0; i < 2; ++i)
#pragma unroll
            for (int r = 0; r < 16; ++r) acc[i][r] = 0.f;
#pragma unroll
        for (int ks = 0; ks < 4; ++ks) {
            const bf16x8 bfr = *(const bf16x8*)(W + (size_t)(d0 + r32) * 64 + ks * 16 + hi * 8);
#pragma unroll
            for (int i = 0; i < 2; ++i) { const bf16x8 af = *(const bf16x8*)(At + (i * 32 + r32) * 264 + gi * 64 + ks * 16 + hi * 8); acc[i] = MFMA32(bfr, af, acc[i]); }
        }
#pragma unroll
        for (int i = 0; i < 2; ++i) {
            const size_t row = (size_t)(r0 + i * 32 + r32);
#pragma unroll
            for (int r4 = 0; r4 < 4; ++r4) {
                const int c = gi * 64 + d0 + 8 * r4 + 4 * hi;
                const f32x4 ps = *(const f32x4*)(p.pool_scale + l * 256 + c);
                const u32x2 gw = *(const u32x2*)(proj + row * NP + C_G + 256 + c);
                u32x2 w; w.x = cvtpk(POOL_OUT_SCALE * acc[i][4 * r4] * ps[0] * siluf_(bflo(gw.x)), POOL_OUT_SCALE * acc[i][4 * r4 + 1] * ps[1] * siluf_(bfhi(gw.x)));
                w.y = cvtpk(POOL_OUT_SCALE * acc[i][4 * r4 + 2] * ps[2] * siluf_(bflo(gw.y)), POOL_OUT_SCALE * acc[i][4 * r4 + 3] * ps[3] * siluf_(bfhi(gw.y)));
                *(u32x2*)(mix + row * DM + 256 + c) = w;
            }
        }
    }
}

DI void s5_unit_rows(int u, int& r0, int& b, int& cidx) {
    if (u < 256) { r0 = u * 128; b = u >> 6; cidx = 2 + (u & 63); } else { const int uc = u - 256; r0 = NLAT + uc * 128; b = uc >> 1; cidx = uc & 1; }
}
DI int s5_rev_order(int i) { return i == 0 ? 1 : (i == 1 ? 0 : 67 - i); }

DI void s5_bu(const bf16x8 ua, int r32, int hi, const bf16x8 (&bR)[2], const bf16x8 (&bI)[2], unsigned* slab) {
    f32x16 z;
#pragma unroll
    for (int r = 0; r < 16; ++r) z[r] = 0.f;
    const f32x16 re0 = MFMA32(ua, bR[0], z), im0 = MFMA32(ua, bI[0], z), re1 = MFMA32(ua, bR[1], z), im1 = MFMA32(ua, bI[1], z);
#pragma unroll
    for (int r = 0; r < 16; ++r) { const int t = crow(r, hi); slab[t * 68 + r32] = cvtpk(re0[r], im0[r]); slab[t * 68 + 32 + r32] = cvtpk(re1[r], im1[r]); }
    asm volatile("" ::: "memory");
}

template <int D, int STORE>
DI void s5_scan32(unsigned* slab, int lane, float lr, float li, float& hr, float& hi_) {
    const f32x2_ lrv = {lr, lr}, liv = {-li, li};
    f32x2_ h = {hr, hi_};
#pragma unroll
    for (int i0 = 0; i0 < 32; i0 += 16) {
        unsigned w[16];
#pragma unroll
        for (int k = 0; k < 16; ++k) { const int t = D ? 31 - (i0 + k) : i0 + k; w[k] = slab[t * 68 + lane]; }
#pragma unroll
        for (int k = 0; k < 16; ++k) {
            const int t = D ? 31 - (i0 + k) : i0 + k;
            const f32x2_ bu = {bflo(w[k]), bfhi(w[k])};
            const f32x2_ hs = __builtin_shufflevector(h, h, 1, 0);
            const f32x2_ inner = __builtin_elementwise_fma(liv, hs, bu);
            h = __builtin_elementwise_fma(lrv, h, inner);
            if (STORE) slab[t * 68 + lane] = cvtpk(h[0], h[1]);
        }
    }
    hr = h[0]; hi_ = h[1];
    asm volatile("" ::: "memory");
}

DI void s5_load_dir(const Params& p, int pidx, int lane, float& lr, float& li, bf16x8 (&bR)[2], bf16x8 (&bI)[2]) {
    const int r32 = lane & 31, hi = lane >> 5;
    lr = ((const float*)(p.ws + OFF_LB))[(pidx + lane) * 2]; li = ((const float*)(p.ws + OFF_LB))[(pidx + lane) * 2 + 1];
#pragma unroll
    for (int pb = 0; pb < 2; ++pb) { bR[pb] = *(const bf16x8*)((const u16*)(p.ws + OFF_BBR) + (size_t)(pidx + pb * 32 + r32) * 16 + hi * 8);
        bI[pb] = *(const bf16x8*)((const u16*)(p.ws + OFF_BBI) + (size_t)(pidx + pb * 32 + r32) * 16 + hi * 8); }
}

template <int D>
DI void s5_p1_dir(const Params& p, int l, int g, int lane, const bf16x8 (&ua)[4], unsigned* slab, float* ep) {
    const int r32 = lane & 31, hi = lane >> 5;
    float lr, li; bf16x8 bR[2], bI[2];
    s5_load_dir(p, ((l * 2 + D) * 16 + g) * 64, lane, lr, li, bR, bI);
    float hr = 0.f, hi_ = 0.f;
#pragma unroll
    for (int sc = 0; sc < 4; ++sc) {
        __builtin_amdgcn_sched_barrier(0);
        s5_bu(ua[D ? 3 - sc : sc], r32, hi, bR, bI, slab);
        __builtin_amdgcn_sched_barrier(0);
        s5_scan32<D, 0>(slab, lane, lr, li, hr, hi_);
    }
    ep[0] = hr; ep[1] = hi_;
}

DI void unit_s5_pass1(const Params& p, int l, int u, unsigned char* smem) {
    const int tid = otid(), wid = __builtin_amdgcn_readfirstlane(tid >> 6), lane = tid & 63, r32 = lane & 31, hi = lane >> 5;
    const u16* proj = (const u16*)(p.ws + OFF_PROJ);
    unsigned* slab = (unsigned*)(smem + wid * 8704);
    int r0, b, cidx; s5_unit_rows(u, r0, b, cidx);
    float* E = (float*)(p.ws + OFF_E);
    __syncthreads();
    bf16x8 ua[2][4];
#pragma unroll
    for (int gg = 0; gg < 2; ++gg)
#pragma unroll
        for (int sc = 0; sc < 4; ++sc) ua[gg][sc] = *(const bf16x8*)(proj + (size_t)(r0 + sc * 32 + r32) * NP + C_S5 + (wid * 2 + gg) * 16 + hi * 8);
#pragma unroll
    for (int gg = 0; gg < 2; ++gg) {
        const int g = wid * 2 + gg;
        s5_p1_dir<0>(p, l, g, lane, ua[gg], slab, E + ((size_t)((0 * 4 + b) * 66 + cidx) * 16 + g) * 128 + lane * 2);
        s5_p1_dir<1>(p, l, g, lane, ua[gg], slab, E + ((size_t)((1 * 4 + b) * 66 + cidx) * 16 + g) * 128 + lane * 2);
    }
}

DI void unit_s5_carry(const Params& p, int l, int u, unsigned* cnt) {
    const int tid = otid();
    const int id = u * 512 + tid;
    const int db = id >> 10, gp = id & 1023, d = db >> 2;
    const float* lb = (const float*)(p.ws + OFF_LB) + (size_t)(((l * 2 + d) * 16) * 64 + gp) * 2;
    float tr = lb[0], ti = lb[1];
#pragma unroll
    for (int i = 0; i < 7; ++i) { const float a = tr * tr - ti * ti, c = 2.f * tr * ti; tr = a; ti = c; }
    float* E = (float*)(p.ws + OFF_E) + ((size_t)db * 66 * 1024 + gp) * 2;
    float hr = 0.f, hi_ = 0.f; asm volatile("" : "+v"(hr), "+v"(hi_));
    for (int i0 = 0; i0 < 66; i0 += 11) {
        float er[11], ei[11];
#pragma unroll
        for (int k = 0; k < 11; ++k) { const int cj = d ? s5_rev_order(i0 + k) : i0 + k; const f32x2_ e = *(const f32x2_*)(E + (size_t)cj * 2048); er[k] = e[0]; ei[k] = e[1]; }
#pragma unroll
        for (int k = 0; k < 11; ++k) {
            const int cj = d ? s5_rev_order(i0 + k) : i0 + k;
            *(f32x2_*)(E + (size_t)cj * 2048) = (f32x2_){hr, hi_};
            const float nr = fmaf(tr, hr, fmaf(-ti, hi_, er[k])), ni = fmaf(tr, hi_, fmaf(ti, hr, ei[k])); hr = nr; hi_ = ni;
        }
    }
    asm volatile("s_waitcnt vmcnt(0)" ::: "memory");
    __syncthreads();
    if (tid == 0) { __threadfence(); __hip_atomic_fetch_add(cnt, 1u, __ATOMIC_RELEASE, __HIP_MEMORY_SCOPE_AGENT); }
}

template <int D>
DI void s5_p2_dir(const Params& p, int l, int g, int lane, const bf16x8 (&ua)[4], unsigned* slab, const float* ep, f32x4 (&Y)[8]) {
    const int r32 = lane & 31, hi = lane >> 5;
    float lr, li; bf16x8 bR[2], bI[2], cm[4];
    const int pidx = ((l * 2 + D) * 16 + g) * 64;
    s5_load_dir(p, pidx, lane, lr, li, bR, bI);
#pragma unroll
    for (int kb = 0; kb < 4; ++kb) cm[kb] = *(const bf16x8*)((const u16*)(p.ws + OFF_CM) + ((size_t)(pidx >> 6) * 16 + (lane & 15)) * 128 + kb * 32 + (lane >> 4) * 8);
    const unsigned long long ev = __hip_atomic_load((const unsigned long long*)ep, __ATOMIC_RELAXED, __HIP_MEMORY_SCOPE_AGENT);
    float hr = __uint_as_float((unsigned)ev), hi_ = __uint_as_float((unsigned)(ev >> 32));
    const unsigned char* sb = (const unsigned char*)slab;
#pragma unroll
    for (int sc = 0; sc < 4; ++sc) {
        const int SC = D ? 3 - sc : sc;
        __builtin_amdgcn_sched_barrier(0);
        s5_bu(ua[SC], r32, hi, bR, bI, slab);
        __builtin_amdgcn_sched_barrier(0);
        s5_scan32<D, 1>(slab, lane, lr, li, hr, hi_);
#pragma unroll
        for (int rb = 0; rb < 2; ++rb)
#pragma unroll
            for (int kb = 0; kb < 4; ++kb) {
                const bf16x8 a = *(const bf16x8*)(sb + (16 * rb + (lane & 15)) * 272 + kb * 64 + (lane >> 4) * 16);
                Y[2 * SC + rb] = MFMA16(a, cm[kb], Y[2 * SC + rb]);
            }
        asm volatile("" ::: "memory");
    }
}

DI void unit_s5_pass2(const Params& p, int l, int u, unsigned char* smem, const unsigned* cnt) {
    const int tid = otid(), wid = __builtin_amdgcn_readfirstlane(tid >> 6), lane = tid & 63, r32 = lane & 31, hi = lane >> 5;
    const u16* proj = (const u16*)(p.ws + OFF_PROJ); u16* mix = (u16*)(p.ws + OFF_H);
    unsigned* slab = (unsigned*)(smem + wid * 8704);
    u16* gy = (u16*)(smem + 8 * 8704);
    int r0, b, cidx; s5_unit_rows(u, r0, b, cidx);
    const float* E = (const float*)(p.ws + OFF_E);
    if (tid == 0) { while (__hip_atomic_load(cnt, __ATOMIC_RELAXED, __HIP_MEMORY_SCOPE_AGENT) < 16u) __builtin_amdgcn_s_sleep(8); }
    __syncthreads();
#pragma unroll
    for (int gg = 0; gg < 2; ++gg) {
        const int g = wid * 2 + gg;
        bf16x8 ua[4];
#pragma unroll
        for (int sc = 0; sc < 4; ++sc) ua[sc] = *(const bf16x8*)(proj + (size_t)(r0 + sc * 32 + r32) * NP + C_S5 + g * 16 + hi * 8);
        f32x4 Y[8];
#pragma unroll
        for (int i = 0; i < 8; ++i) Y[i] = (f32x4){0.f, 0.f, 0.f, 0.f};
        s5_p2_dir<0>(p, l, g, lane, ua, slab, E + ((size_t)((0 * 4 + b) * 66 + cidx) * 16 + g) * 128 + lane * 2, Y);
        s5_p2_dir<1>(p, l, g, lane, ua, slab, E + ((size_t)((1 * 4 + b) * 66 + cidx) * 16 + g) * 128 + lane * 2, Y);
        int lnb = lane; asm volatile("" : "+v"(lnb));
        const int c = g * 16 + (lnb & 15); const float dsk = p.s5_d[l * 256 + c];
#pragma unroll
        for (int i = 0; i < 8; ++i)
#pragma unroll
            for (int r = 0; r < 4; ++r) {
                const int t = 16 * i + (lnb >> 4) * 4 + r;
                const float y = Y[i][r] + bf2f(proj[(size_t)(r0 + t) * NP + C_S5 + c]) * dsk;
                gy[t * 264 + c] = f2bf(gelu_tanh(y));
            }
    }
    __syncthreads();
    {
        const int tid2 = otid(), r32 = tid2 & 31, hi = (tid2 >> 5) & 1;
        const int n0 = wid * 32;
        const u16* W = (const u16*)(p.ws + OFF_WTGLU) + (size_t)l * 256 * 256;
        f32x16 acc[4];
#pragma unroll
        for (int i = 0; i < 4; ++i)
#pragma unroll
            for (int r = 0; r < 16; ++r) acc[i][r] = 0.f;
        bf16x8 bfr[16];
#pragma unroll
        for (int ks = 0; ks < 16; ++ks) bfr[ks] = *(const bf16x8*)(W + (size_t)(n0 + r32) * 256 + ks * 16 + hi * 8);
#pragma unroll
        for (int ks = 0; ks < 16; ++ks) {
#pragma unroll
            for (int i = 0; i < 4; ++i) { const bf16x8 af = *(const bf16x8*)(gy + (i * 32 + r32) * 264 + ks * 16 + hi * 8); acc[i] = MFMA32(bfr[ks], af, acc[i]); }
        }
#pragma unroll
        for (int i = 0; i < 4; ++i) {
            const int t = i * 32 + r32; const size_t row = (size_t)(r0 + t);
#pragma unroll
            for (int r4 = 0; r4 < 4; ++r4) {
                const int n = n0 + 8 * r4 + 4 * hi;
                const f32x4 bg = *(const f32x4*)(p.b_glu + l * 256 + n);
                const u32x2 yw = *(const u32x2*)(gy + t * 264 + n), gw = *(const u32x2*)(proj + row * NP + C_G + 512 + n);
                const float o0 = bflo(yw.x) * sigmoidf_(acc[i][4 * r4] + bg[0]) * siluf_(bflo(gw.x)), o1 = bfhi(yw.x) * sigmoidf_(acc[i][4 * r4 + 1] + bg[1]) * siluf_(bfhi(gw.x));
                const float o2 = bflo(yw.y) * sigmoidf_(acc[i][4 * r4 + 2] + bg[2]) * siluf_(bflo(gw.y)), o3 = bfhi(yw.y) * sigmoidf_(acc[i][4 * r4 + 3] + bg[3]) * siluf_(bfhi(gw.y));
                u32x2 w; w.x = cvtpk(S5_OUT_SCALE * o0, S5_OUT_SCALE * o1); w.y = cvtpk(S5_OUT_SCALE * o2, S5_OUT_SCALE * o3);
                *(u32x2*)(mix + row * DM + 512 + n) = w;
            }
        }
    }
}

constexpr int AT_V = 64 * 64 * 2, AT_K = 64 * 256, AT_LDS = 2 * AT_V + 2 * AT_K + 8 * 64 * 4;
#ifndef ATT_OUT_SCALE
#define ATT_OUT_SCALE 1.f
#endif
constexpr float AT_THR = 11.5f;
#define KSWZ(row, colB) ((row) * 256 + ((colB) ^ (((row) & 7) << 4)))
#define SBAR() __builtin_amdgcn_sched_barrier(0)
#define LSBAR() do {} while (0)
template <bool FIRST>
DI void partialSM(f32x16& p0, f32x16& p1, float& m_reg, f32x16& negm, float& alpha) {
    float pmax = p0[0];
#pragma unroll
    for (int r = 1; r < 16; ++r) pmax = fmaxf(pmax, p0[r]);
#pragma unroll
    for (int r = 0; r < 16; ++r) pmax = fmaxf(pmax, p1[r]);
    { auto rr = __builtin_amdgcn_permlane32_swap(__float_as_uint(pmax), __float_as_uint(pmax), false, false);
      pmax = fmaxf(__uint_as_float(rr[0]), __uint_as_float(rr[1])); }
    if (!FIRST && __builtin_expect(__all(pmax <= AT_THR), 1)) { alpha = 1.f; }
    else {
        const float delta = FIRST ? pmax : fmaxf(pmax, 0.f);
        alpha = FIRST ? 1.f : fexp2(-delta); m_reg += delta;
#pragma unroll
        for (int r = 0; r < 16; ++r) { p0[r] -= delta; p1[r] -= delta; negm[r] = -m_reg; }
    }
#pragma unroll
    for (int r = 0; r < 16; ++r) p0[r] = fexp2(p0[r]);
}
DI void finishSM(f32x16& p0, f32x16& p1, bf16x8& pa0, bf16x8& pa1, bf16x8& pa2, bf16x8& pa3) {
#pragma unroll
    for (int r = 0; r < 16; ++r) p1[r] = fexp2(p1[r]);
#define PK4(P, BASE, OUT) do { unsigned a0 = cvtpk(P[BASE + 0], P[BASE + 1]), a1 = cvtpk(P[BASE + 2], P[BASE + 3]);   \
    unsigned b0 = cvtpk(P[BASE + 4], P[BASE + 5]), b1 = cvtpk(P[BASE + 6], P[BASE + 7]);                              \
    auto r0 = __builtin_amdgcn_permlane32_swap(a0, b0, false, false); auto r1 = __builtin_amdgcn_permlane32_swap(a1, b1, false, false); \
    u32x4 w = {r0[0], r1[0], r0[1], r1[1]}; OUT = *reinterpret_cast<bf16x8*>(&w); } while (0)
    PK4(p0, 0, pa0); PK4(p0, 8, pa1); PK4(p1, 0, pa2); PK4(p1, 8, pa3);
#undef PK4
}
DI void qkt(f32x16& p0, f32x16& p1, const unsigned char* Ks, const bf16x8* qr, int r32, int hi, const f32x16& negm) {
    p0 = negm; p1 = negm;
#pragma unroll
    for (int d0 = 0; d0 < 6; ++d0) { const int cb = (d0 * 16 + hi * 8) * 2;
        const bf16x8 b0 = *reinterpret_cast<const bf16x8*>(Ks + KSWZ(r32, cb));
        const bf16x8 b1 = *reinterpret_cast<const bf16x8*>(Ks + KSWZ(32 + r32, cb));
        p0 = MFMA32(b0, qr[d0], p0);
        p1 = MFMA32(b1, qr[d0], p1); }
}
DI int v_st(int k, int c) { const int kk = (k & ~0xC) | ((k & 4) << 1) | ((k & 8) >> 1); return ((kk >> 3) * 2 + (c >> 5)) * 512 + ((kk & 7) * 32 + (c & 31)) * 2; }
DI int v_rd_base(int lane) { return ((lane & 3) << 3) | (((lane >> 2) & 3) << 6) | (((lane >> 4) & 1) << 5) | (((lane >> 5) & 1) << 8); }
constexpr int v_rd_off(int d0, int ks, int half) { return d0 * 512 + ks * 2048 + half * 1024; }
template <int OFF> DI s16x4 tr_read(int vb) { s16x4 r; asm volatile("ds_read_b64_tr_b16 %0, %1 offset:%2" : "=&v"(r) : "v"(vb), "i"(OFF) : "memory"); return r; }
template <int D0> DI void pv_one(f32x16& od, int vb, bf16x8 pa0, bf16x8 pa1, bf16x8 pa2, bf16x8 pa3) {
    const s16x4 l0 = tr_read<v_rd_off(D0, 0, 0)>(vb), h0 = tr_read<v_rd_off(D0, 0, 1)>(vb), l1 = tr_read<v_rd_off(D0, 1, 0)>(vb), h1 = tr_read<v_rd_off(D0, 1, 1)>(vb);
    const s16x4 l2 = tr_read<v_rd_off(D0, 2, 0)>(vb), h2 = tr_read<v_rd_off(D0, 2, 1)>(vb), l3 = tr_read<v_rd_off(D0, 3, 0)>(vb), h3 = tr_read<v_rd_off(D0, 3, 1)>(vb);
    asm volatile("s_waitcnt lgkmcnt(0)" ::: "memory"); SBAR();
#define PK(L, H) (bf16x8){L[0], L[1], L[2], L[3], H[0], H[1], H[2], H[3]}
    od = MFMA32(pa0, PK(l0, h0), od);
    od = MFMA32(pa1, PK(l1, h1), od);
    od = MFMA32(pa2, PK(l2, h2), od);
    od = MFMA32(pa3, PK(l3, h3), od);
#undef PK
}
DI void pv_d0(f32x16* o, int vb, bf16x8 pa0, bf16x8 pa1, bf16x8 pa2, bf16x8 pa3) {
    pv_one<0>(o[0], vb, pa0, pa1, pa2, pa3); pv_one<1>(o[1], vb, pa0, pa1, pa2, pa3);
    const bf16x8 ones = {0x3F80, 0x3F80, 0x3F80, 0x3F80, 0x3F80, 0x3F80, 0x3F80, 0x3F80};
    o[2] = MFMA32(pa0, ones, o[2]); o[2] = MFMA32(pa1, ones, o[2]); o[2] = MFMA32(pa2, ones, o[2]); o[2] = MFMA32(pa3, ones, o[2]);
}

DI void attn_unit(const u16* __restrict__ Qb, const u16* __restrict__ Kh, const u16* __restrict__ Vh, int nkeys, int row0, int h, const Params& p, unsigned char* lds) {
    const int tid = otid(), wid = __builtin_amdgcn_readfirstlane(tid >> 6), lane = tid & 63, r32 = lane & 31, hi = lane >> 5;
    unsigned char* V_lds = lds; unsigned char* K_lds = lds + 2 * AT_V;
    float* wsl = (float*)(lds + 2 * AT_V + 2 * AT_K) + wid * 64; float* al_l = wsl + 32;
    float m_reg = 0.f; f32x16 o[3], negm; bf16x8 qr[6];
#pragma unroll
    for (int r = 0; r < 16; ++r) negm[r] = 0.f;
#pragma unroll
    for (int d = 0; d < 3; ++d)
#pragma unroll
        for (int r = 0; r < 16; ++r) o[d][r] = 0.f;
    const u16* Qw = Qb + (size_t)(wid * 32 + r32) * 96 + hi * 8;
#pragma unroll
    for (int d0 = 0; d0 < 6; ++d0) qr[d0] = *(const bf16x8*)(Qw + d0 * 16);
    const int vst = v_st(tid >> 3, (tid & 7) * 8);
    const int kc0 = tid, kc1 = 512 + (tid & 255);
    const int kst0 = KSWZ(kc0 / 12, (kc0 % 12) * 16), kst1 = KSWZ(kc1 / 12, (kc1 % 12) * 16);
    const bool k2 = tid < 256;
    const int vb0 = (int)(uintptr_t)V_lds + v_rd_base(lane);
    struct { bf16x8 vs, ks0, ks1; } sr_[2];
#define SLOAD(i, k0) do { sr_[i].vs = *(const bf16x8*)(Vh + (size_t)(k0) * 64 + tid * 8); sr_[i].ks0 = *(const bf16x8*)(Kh + (size_t)(k0) * 96 + kc0 * 8); \
    sr_[i].ks1 = *(const bf16x8*)(Kh + (size_t)(k0) * 96 + kc1 * 8); } while (0)
#define SWRITE(b, i) do { *(bf16x8*)(V_lds + (b) * AT_V + vst) = sr_[i].vs; *(bf16x8*)(K_lds + (b) * AT_K + kst0) = sr_[i].ks0; \
    if (k2) *(bf16x8*)(K_lds + (b) * AT_K + kst1) = sr_[i].ks1; } while (0)
#define SWAIT() asm volatile("s_waitcnt vmcnt(3)" ::: "memory")
#define RESC(a) do { if (__any((a) < 1.f)) { if (hi == 0) al_l[r32] = (a); asm volatile("s_waitcnt lgkmcnt(0)" ::: "memory"); \
    _Pragma("unroll") for (int d = 0; d < 3; ++d) _Pragma("unroll") for (int r = 0; r < 16; ++r) o[d][r] *= al_l[crow(r, hi)]; } } while (0)
    f32x16 pA0, pA1, pB0, pB1; float alA, alB; bf16x8 pa0, pa1, pa2, pa3; const int NT = nkeys / 64;
    constexpr int SE = 0, SO = 1;
    __syncthreads();
    SLOAD(SE, 0); asm volatile("s_waitcnt vmcnt(0)" ::: "memory"); SWRITE(0, SE); __syncthreads();
    qkt(pA0, pA1, K_lds, qr, r32, hi, negm); partialSM<true>(pA0, pA1, m_reg, negm, alA);
    SLOAD(SO, 64); if (2 < NT) SLOAD(SE, 128);
    SWAIT(); SWRITE(1, SO); __syncthreads();
    for (int j = 1; j + 1 < NT; j += 2) {
        LSBAR(); qkt(pB0, pB1, K_lds + AT_K, qr, r32, hi, negm);
        finishSM(pA0, pA1, pa0, pa1, pa2, pa3); LSBAR();
        SLOAD(SO, (j + 2) * 64); LSBAR();
        pv_d0(o, vb0, pa0, pa1, pa2, pa3); partialSM<false>(pB0, pB1, m_reg, negm, alB);
        __syncthreads(); SWAIT(); SWRITE(0, SE);
        RESC(alB); __syncthreads();
        LSBAR(); qkt(pA0, pA1, K_lds, qr, r32, hi, negm);
        finishSM(pB0, pB1, pa0, pa1, pa2, pa3); LSBAR();
        if (j + 3 < NT) SLOAD(SE, (j + 3) * 64); LSBAR();
        pv_d0(o, vb0 + AT_V, pa0, pa1, pa2, pa3); partialSM<false>(pA0, pA1, m_reg, negm, alA);
        __syncthreads(); SWAIT(); SWRITE(1, SO);
        RESC(alA); __syncthreads();
    }
    LSBAR(); qkt(pB0, pB1, K_lds + AT_K, qr, r32, hi, negm);
    finishSM(pA0, pA1, pa0, pa1, pa2, pa3); LSBAR();
    pv_d0(o, vb0, pa0, pa1, pa2, pa3); partialSM<false>(pB0, pB1, m_reg, negm, alB);
    __syncthreads(); RESC(alB);
    finishSM(pB0, pB1, pa0, pa1, pa2, pa3); LSBAR();
    pv_d0(o, vb0 + AT_V, pa0, pa1, pa2, pa3);
    const u16* proj = (const u16*)(p.ws + OFF_PROJ); u16* mix = (u16*)(p.ws + OFF_H);
#pragma unroll
    for (int r = 0; r < 16; ++r) {
        const int orow = row0 + wid * 32 + crow(r, hi); const float rl = __builtin_amdgcn_rcpf(o[2][r]);
#pragma unroll
        for (int d0 = 0; d0 < 2; ++d0) {
            const int c = h * 64 + d0 * 32 + r32;
            const float gt = bf2f(proj[(size_t)orow * NP + C_G + c]);
            mix[(size_t)orow * DM + c] = f2bf(ATT_OUT_SCALE * o[d0][r] * rl * siluf_(gt));
        }
    }
#undef SLOAD
#undef SWRITE
#undef SWAIT
#undef RESC
}
#define XB_TMO      128
#define XB_XCNT(j)  (256  + 64 * (j))
#define XB_XSUB(j)  (1280 + 64 * (j))
#define XB_XGEN(j)  (2304 + 64 * (j))
#define XB_TOP      3328
#define XB_TOPGEN   3392
#define XCD_BAR_WORDS 3456
#define XB_SPIN_CAP (1u << 18)
#define LAS __attribute__((address_space(3)))

__device__ __forceinline__ unsigned xb_ld(unsigned* p)              { return __hip_atomic_load(p, __ATOMIC_RELAXED, __HIP_MEMORY_SCOPE_AGENT); }
__device__ __forceinline__ unsigned xb_add(unsigned* p, unsigned v) { return __hip_atomic_fetch_add(p, v, __ATOMIC_RELAXED, __HIP_MEMORY_SCOPE_AGENT); }
__device__ __forceinline__ unsigned xb_xcc_id() { return (unsigned)__builtin_amdgcn_s_getreg((3 << 11) | 20) & 0xFu; }
#define XB_SPIN(cond, bar) do { unsigned _sp = 0; while (cond) { __builtin_amdgcn_s_sleep(1); \
    if ((++_sp & 255u) == 0u) { if (xb_ld(&(bar)[XB_TMO])) break; if (_sp > XB_SPIN_CAP) { atomicAdd(&(bar)[XB_TMO], 1u); break; } } } } while (0)

struct XcdBarrier {
    unsigned* bar; unsigned x;
    volatile LAS unsigned* st;
};

__device__ __forceinline__ XcdBarrier xcd_barrier_post(unsigned* bar, volatile LAS unsigned* st) {
    XcdBarrier b; b.bar = bar; b.x = xb_xcc_id(); b.st = st;
    if (threadIdx.x == 0) (void)xb_add(&bar[XB_XCNT(b.x)], 1u);
    return b;
}
__device__ __forceinline__ void xcd_barrier_complete(unsigned* bar, unsigned x, unsigned& nloc, unsigned& nx) {
    const unsigned G = gridDim.x * gridDim.y * gridDim.z;
    unsigned sum, cnt, mine, sp = 0u;
    for (;;) {
        sum = 0u; cnt = 0u; mine = 0u;
#pragma unroll
        for (unsigned j = 0; j < 16; ++j) { const unsigned c = xb_ld(&bar[XB_XCNT(j)]); sum += c; cnt += (c > 0u) ? 1u : 0u; mine = (j == x) ? c : mine; }
        if (sum == G) break;
        __builtin_amdgcn_s_sleep(1);
        if ((++sp & 255u) == 0u) { if (xb_ld(&bar[XB_TMO])) break; if (sp > XB_SPIN_CAP) { atomicAdd(&bar[XB_TMO], 1u); break; } }
    }
    nloc = mine > 0u ? mine : 1u; nx = cnt > 0u ? cnt : 1u;
}

__device__ __forceinline__ void xcd_barrier(const XcdBarrier& b) {
    asm volatile("s_waitcnt vmcnt(0)" ::: "memory");
    __syncthreads();
    if (threadIdx.x == 0) {
        unsigned* bar = b.bar;
        __builtin_amdgcn_s_waitcnt(0);
        unsigned nloc = b.st[0], nx = b.st[1];
        if (nloc == 0u) { xcd_barrier_complete(bar, b.x, nloc, nx); b.st[0] = nloc; b.st[1] = nx; }
        const unsigned old = xb_add(&bar[XB_XSUB(b.x)], 1u);
        const unsigned gen = old / nloc;
        if (old + 1u == (gen + 1u) * nloc) {
            __builtin_amdgcn_fence(__ATOMIC_RELEASE, "agent");
            asm volatile("s_waitcnt vmcnt(0)" ::: "memory");
            const unsigned og = xb_add(&bar[XB_TOP], 1u);
            const unsigned tg = og / nx;
            if (og + 1u == (tg + 1u) * nx) xb_add(&bar[XB_TOPGEN], 1u);
            else XB_SPIN(xb_ld(&bar[XB_TOPGEN]) == tg, bar);
            __builtin_amdgcn_fence(__ATOMIC_ACQUIRE, "agent");
            xb_add(&bar[XB_XGEN(b.x)], 1u);
            asm volatile("s_waitcnt vmcnt(0)" ::: "memory");
        } else {
            XB_SPIN(xb_ld(&bar[XB_XGEN(b.x)]) == gen, bar);
            __builtin_amdgcn_fence(__ATOMIC_ACQUIRE, "agent");
            asm volatile("s_waitcnt vmcnt(0)" ::: "memory");
        }
    }
    __syncthreads();
}

#ifndef RC_S5
#define RC_S5 1
#endif
#ifndef RC_SGU
#define RC_SGU 1
#endif
#ifndef RC_MLA
#define RC_MLA 1
#endif
#ifndef RC_POOL
#define RC_POOL 1
#endif
DI void phase_c(const Params& p, int l, unsigned char* smem) {
    const int last = (l == 1);
    const int n_g = last ? 8 : 40, n_s5c = 8, n_sguc = last ? 0 : 8, n_mlac = 16, n_poolc = last ? 0 : 16;
    const int total = n_g + 256 + 256 + 512 + 512 + n_s5c + n_sguc + n_mlac + n_poolc;
    unsigned* queue = (unsigned*)(p.ws + OFF_CNT) + 32 + l * 16;
    unsigned* gdone = (unsigned*)(p.ws + OFF_CNT) + 8 + l * 4;
    volatile LAS int* nx = (volatile LAS int*)(smem + LDS_BYTES - 4);
    int u = blockIdx.x;
    while (u < total) {
        int nxt = 0;
        if (threadIdx.x == 0) nxt = (int)gridDim.x + (int)__hip_atomic_fetch_add(queue, 1u, __ATOMIC_RELAXED, __HIP_MEMORY_SCOPE_AGENT);
        int v = u;
        if (v < n_g) unit_gemm_ctx(p, l, v, smem, gdone);
        else if ((v -= n_g) < 256) unit_s5_pass1(p, l, v, smem);
        else if ((v -= 256) < 256) unit_sgu(p, l, v, smem);
        else if ((v -= 256) < 512) unit_mla(p, l, v, smem);
        else if ((v -= 512) < 512) unit_pool(p, l, v, smem);
        else {
            v -= 512;
            if (threadIdx.x == 0) { while (__hip_atomic_load(gdone, __ATOMIC_RELAXED, __HIP_MEMORY_SCOPE_AGENT) < (unsigned)n_g) __builtin_amdgcn_s_sleep(8); }
            __syncthreads();
            if (v < n_s5c) unit_s5_pass1(p, l, 256 + v, smem);
            else if ((v -= n_s5c) < n_sguc) unit_sgu(p, l, 256 + v, smem);
            else if ((v -= n_sguc) < n_mlac) unit_mla(p, l, 512 + v, smem);
            else unit_pool(p, l, 512 + (v - n_mlac), smem);
        }
        if (threadIdx.x == 0) nx[0] = nxt;
        __syncthreads();
        u = __builtin_amdgcn_readfirstlane(nx[0]);
    }
}

#ifndef RD_ATT
#define RD_ATT 1
#endif
#ifndef RD_S5
#define RD_S5 1
#endif
DI void phase_d(const Params& p, int l, unsigned char* smem) {
    const int last = (l == 1);
    const u16* Qg = (const u16*)(p.ws + OFF_Q); const u16* Kg = (const u16*)(p.ws + OFF_K); const u16* Vg = (const u16*)(p.ws + OFF_V);
    unsigned* cnt = (unsigned*)(p.ws + OFF_CNT) + l * 16;
    for (int uu = blockIdx.x; uu < 16 + 512; uu += gridDim.x) {
        if (uu < 16) { unit_s5_carry(p, l, uu, cnt); continue; }
        const int u = uu - 16;
        const int bh = (u & 7) + 8 * (u >> 8), qb = (u >> 3) & 31, b = bh >> 2, h = bh & 3;
        for (int q = 0; q < RD_ATT; ++q) attn_unit(Qg + ((size_t)bh * SKV + 256 + qb * 256) * 96, Kg + (size_t)bh * SKV * 96, Vg + (size_t)bh * SKV * 64, SKV, b * SEQ + qb * 256, h, p, smem);
    }
    const int n_cs5 = last ? 0 : 8, n_catt = last ? 0 : 16, n_ge = last ? 0 : 16;
    const int total = n_cs5 + n_catt + 256 + n_ge;
    unsigned* queue = (unsigned*)(p.ws + OFF_CNT) + 36 + l * 16;
    unsigned* mixdone = (unsigned*)(p.ws + OFF_CNT) + 10;
    volatile LAS int* nx = (volatile LAS int*)(smem + LDS_BYTES - 4);
    int u = blockIdx.x;
    while (u < total) {
        int nxt = 0;
        if (threadIdx.x == 0) nxt = (int)gridDim.x + (int)__hip_atomic_fetch_add(queue, 1u, __ATOMIC_RELAXED, __HIP_MEMORY_SCOPE_AGENT);
        int v = u;
        if (v < n_cs5) { unit_s5_pass2(p, l, 256 + v, smem, cnt); publish_unit(mixdone); }
        else if ((v -= n_cs5) < n_catt) {
            const int b = v >> 2, h = v & 3;
            attn_unit(Qg + (size_t)v * SKV * 96, Kg + (size_t)v * SKV * 96, Vg + (size_t)v * SKV * 64, CTXL, NLAT + b * CTXL, h, p, smem);
            publish_unit(mixdone);
        }
        else if ((v -= n_catt) < 256) { for (int q = 0; q < RD_S5; ++q) unit_s5_pass2(p, l, v, smem, cnt); }
        else { v -= 256; wait_units(mixdone, 24u); unit_gemm_one((const u16*)(p.ws + OFF_H), (const u16*)(p.ws + OFF_WTOUT), (u16*)(p.ws + OFF_Y), DM, 128 + (v >> 2), v & 3, smem); }
        if (threadIdx.x == 0) nx[0] = nxt;
        __syncthreads();
        u = __builtin_amdgcn_readfirstlane(nx[0]);
    }
}

DI void gsync(const XcdBarrier& b) { xcd_barrier(b); }
DI void gsync_cg(cg::grid_group& g) {
    asm volatile("s_waitcnt vmcnt(0) lgkmcnt(0)" ::: "memory");
    g.sync();
    asm volatile("buffer_inv sc1\n\ts_waitcnt vmcnt(0)" ::: "memory");
}
#ifndef REP_SYNC
#define REP_SYNC 0
#endif
#ifndef REP_W
#define REP_W 1
#endif
#ifndef REP_A
#define REP_A 1
#endif
#ifndef REP_B
#define REP_B 1
#endif
#ifndef REP_C
#define REP_C 1
#endif
#ifndef REP_D
#define REP_D 1
#endif
#ifndef REP_E
#define REP_E 1
#endif
#ifndef REP_F
#define REP_F 1
#endif
__global__ void __launch_bounds__(512) fwd_megakernel(Params p) {
    extern __shared__ __attribute__((aligned(16))) unsigned char smem[];
    cg::grid_group grid = cg::this_grid();
    volatile LAS unsigned* xst = (volatile LAS unsigned*)(smem + LDS_BYTES - 16);
    if (threadIdx.x < 4) xst[threadIdx.x] = 0u;
    __syncthreads();
    const XcdBarrier xb = xcd_barrier_post((unsigned*)(p.ws + OFF_BAR), xst);
    u16* hb = (u16*)(p.ws + OFF_H); u16* proj = (u16*)(p.ws + OFF_PROJ); u16* yb = (u16*)(p.ws + OFF_Y);
    if (p.ws == nullptr) gsync_cg(grid);
    for (int rep = 0; rep < REP_W; ++rep) { phase_w(p, smem); gsync(xb); }
    for (int rep = 0; rep < REP_A; ++rep) { phase_a(p, smem); gsync(xb); }
    for (int rep = 0; rep < REP_SYNC; ++rep) gsync(xb);
    for (int l = 0; l < 2; ++l) {
        for (int rep = 0; rep < REP_B; ++rep) { phase_gemm(hb, (const u16*)(p.ws + OFF_WTIN) + (size_t)l * NP * DM, proj, NLAT, NP, NP, smem); gsync(xb); }
        for (int rep = 0; rep < REP_C; ++rep) { phase_c(p, l, smem); gsync(xb); }
        for (int rep = 0; rep < REP_D; ++rep) { phase_d(p, l, smem); gsync(xb); }
        for (int rep = 0; rep < REP_E; ++rep) { phase_gemm(hb, (const u16*)(p.ws + OFF_WTOUT) + (size_t)l * DM * DM, yb, NLAT, DM, DM, smem); gsync(xb); }
        if (l == 0) { for (int rep = 0; rep < REP_F; ++rep) { phase_f(p, l, smem); gsync(xb); } } else phase_f(p, l, smem);
    }
}

extern "C" void kernel_launch(void* const* d_in, const int* in_sizes, int n_in, void* d_out, int out_size, void* d_ws, size_t ws_size, hipStream_t stream) {
    static int grid_blocks = 0;
    if (grid_blocks == 0) {
        if (n_in != 30 || out_size != NLAT * DM || ws_size < WS_END) { fprintf(stderr, "kernel_launch: unexpected shapes (n_in %d out %d ws %zu need %zu)\n", n_in, out_size, ws_size, (size_t)WS_END); grid_blocks = -1; return; }
        int dev = 0, cus = 0, per_cu = 0;
        hipGetDevice(&dev);
        hipDeviceGetAttribute(&cus, hipDeviceAttributeMultiprocessorCount, dev);
        if (hipFuncSetAttribute((const void*)fwd_megakernel, hipFuncAttributeMaxDynamicSharedMemorySize, LDS_BYTES) != hipSuccess) { fprintf(stderr, "kernel_launch: hipFuncSetAttribute failed\n"); grid_blocks = -1; return; }
        hipOccupancyMaxActiveBlocksPerMultiprocessor(&per_cu, (const void*)fwd_megakernel, 512, LDS_BYTES);
        if (per_cu < 1) { fprintf(stderr, "kernel_launch: occupancy query says %d blocks per CU\n", per_cu); per_cu = 1; }
        grid_blocks = cus * per_cu;
    }
    if (grid_blocks < 0) return;
    if (hipMemsetAsync((char*)d_ws + OFF_BAR, 0, BAR_BYTES, stream) != hipSuccess) { fprintf(stderr, "kernel_launch: hipMemsetAsync failed\n"); return; }
    Params p{};
    const float** pp = (const float**)&p;
    for (int i = 0; i < 30; ++i) pp[i] = (const float*)d_in[i];
    p.out = (float*)d_out; p.ws = (unsigned char*)d_ws;
    void* args[] = {&p};
    hipError_t e = hipLaunchCooperativeKernel((const void*)fwd_megakernel, dim3(grid_blocks), dim3(512), args, LDS_BYTES, stream);
    if (e != hipSuccess) fprintf(stderr, "cooperative launch failed: %s (grid %d)\n", hipGetErrorString(e), grid_blocks);
}
```
